# Optimizing an MI355X kernel written in HIP

```python
import math
import jax, jax.numpy as jnp
from jax import lax
import numpy as np

D_MODEL = 2048
BATCH = 2
SEQ = 4096
DEPTH = 2

D_MIX = D_MODEL
RW_HEADS = 12
RW_HD = 64
RW_W = RW_HEADS * RW_HD
RW_DECAY_LORA = 64
RW_AAA_LORA = 64
RW_GATE_LORA = 128
RW_GN_EPS = 64e-5
DA_HEADS = 6
DA_HD = 64
DA_W = DA_HEADS * 2 * DA_HD
DA_SUBLN_EPS = 1e-5
Q_BLOCK = 128
SSM_W = D_MIX - RW_W - DA_W
SSM_GROUP = 16
SSM_GROUPS = SSM_W // SSM_GROUP
SSM_STATE = 64
RW_COLS = 3 * RW_W + RW_DECAY_LORA + RW_AAA_LORA + RW_GATE_LORA
DA_COLS = 3 * DA_W
IN_COLS = RW_COLS + DA_COLS + SSM_W
D_FF = 5504
NORM_EPS = 1e-6

kernel_name = "hybrid_rwkv7_diffattn_s5_macaron"


def rms_norm(x, g):
    xf = x.astype(jnp.float32)
    y = xf * lax.rsqrt(jnp.mean(xf * xf, axis=-1, keepdims=True) + NORM_EPS)
    return y.astype(x.dtype) * g


def swiglu(h, w_gu, w_down):
    gate, up = jnp.split(h @ w_gu, 2, axis=-1)
    return (jax.nn.silu(gate) * up) @ w_down


def rwkv7_mix(z, mu, w0, w2, a0, a2, g2, k_k, k_a, r_k, gn_w, gn_b):
    f32 = jnp.float32
    b_, t_, _ = z.shape
    z_prev = jnp.pad(z, ((0, 0), (1, 0), (0, 0)))[:, :-1]
    z = z + (z_prev - z) * mu
    o1, o2, o3 = RW_W, 2 * RW_W, 3 * RW_W
    o4, o5 = o3 + RW_DECAY_LORA, o3 + RW_DECAY_LORA + RW_AAA_LORA
    r, k, v = z[..., :o1], z[..., o1:o2], z[..., o2:o3]
    zw, za, zg = z[..., o3:o4], z[..., o4:o5], z[..., o5:]
    w = -jax.nn.softplus(-(w0 + jnp.tanh(zw) @ w2)) - 0.5
    decay = jnp.exp(-jnp.exp(w.astype(f32)))
    a = jax.nn.sigmoid(a0 + za @ a2)
    g = jax.nn.sigmoid(zg) @ g2
    hs = lambda t: t.reshape(b_, t_, RW_HEADS, RW_HD).astype(f32)
    r, k, v, decay, a = hs(r), hs(k), hs(v), hs(decay), hs(a)
    kk = k * k_k.reshape(RW_HEADS, RW_HD).astype(f32)
    kk = kk / jnp.maximum(jnp.sqrt(jnp.sum(kk * kk, axis=-1, keepdims=True)), 1e-12)
    k = k * (1.0 + (a - 1.0) * k_a.reshape(RW_HEADS, RW_HD).astype(f32))
    rem_a = -kk
    rem_b = kk * a

    def step(S, inp):
        r_t, w_t, k_t, v_t, a_t, b_t = inp
        sa = jnp.einsum('bhvk,bhk->bhv', S, a_t)
        S = S * w_t[:, :, None, :] + sa[..., None] * b_t[:, :, None, :] + v_t[..., None] * k_t[:, :, None, :]
        return S, jnp.einsum('bhvk,bhk->bhv', S, r_t)

    S0 = jnp.zeros((b_, RW_HEADS, RW_HD, RW_HD), f32)
    seq_first = tuple(t.transpose(1, 0, 2, 3) for t in (r, decay, k, v, rem_a, rem_b))
    _, y = lax.scan(step, S0, seq_first)
    y = y.transpose(1, 0, 2, 3)
    mean = jnp.mean(y, axis=-1, keepdims=True)
    var = jnp.mean(jnp.square(y - mean), axis=-1, keepdims=True)
    y = ((y - mean) * lax.rsqrt(var + RW_GN_EPS)).reshape(b_, t_, RW_W) * gn_w + gn_b
    bonus = jnp.sum(r * k * r_k.astype(f32), axis=-1, keepdims=True) * v
    y = (y + bonus.reshape(b_, t_, RW_W)) * g
    return y.astype(z.dtype)


def diff_attn_mix(z, lq1, lk1, lq2, lk2, subln_w, lam_init):
    f32 = jnp.float32
    b_, t_, _ = z.shape
    q = z[..., :DA_W].reshape(b_, t_, DA_HEADS, 2, DA_HD).astype(f32)
    k = z[..., DA_W:2 * DA_W].reshape(b_, t_, DA_HEADS, 2, DA_HD).astype(f32)
    v = z[..., 2 * DA_W:].reshape(b_, t_, DA_HEADS, 2 * DA_HD).astype(f32)
    lam = (jnp.exp(jnp.sum(lq1.astype(f32) * lk1.astype(f32)))
           - jnp.exp(jnp.sum(lq2.astype(f32) * lk2.astype(f32))) + lam_init)
    nb = t_ // Q_BLOCK
    qb = q.reshape(b_, nb, Q_BLOCK, DA_HEADS, 2, DA_HD).transpose(1, 0, 2, 3, 4, 5) * (DA_HD ** -0.5)
    kpos = jnp.arange(t_)

    def block(args):
        q_blk, blk = args
        s = jnp.einsum('bqhcd,bkhcd->bhcqk', q_blk, k)
        qpos = blk * Q_BLOCK + jnp.arange(Q_BLOCK)
        s = jnp.where(kpos[None, :] <= qpos[:, None], s, -jnp.inf)
        p = jax.nn.softmax(s, axis=-1)
        attn = p[:, :, 0] - lam * p[:, :, 1]
        return jnp.einsum('bhqk,bkhe->bqhe', attn, v)

    o = lax.map(block, (qb, jnp.arange(nb)))
    o = o.transpose(1, 0, 2, 3, 4).reshape(b_, t_, DA_HEADS, 2 * DA_HD)
    o = o * lax.rsqrt(jnp.mean(o * o, axis=-1, keepdims=True) + DA_SUBLN_EPS) * subln_w.astype(f32)
    o = o * (1.0 - lam_init)
    return o.reshape(b_, t_, DA_W).astype(z.dtype)


def _complex_linear_combine(e1, e2):
    a1r, a1i, b1r, b1i = e1
    a2r, a2i, b2r, b2i = e2
    return (a2r * a1r - a2i * a1i,
            a2r * a1i + a2i * a1r,
            a2r * b1r - a2i * b1i + b2r,
            a2r * b1i + a2i * b1r + b2i)


def s5_mix(u, a_re, a_im, log_dt, b_re, b_im, c_re, c_im, d_skip, w_glu, b_glu):
    f32 = jnp.float32
    b_, t_, _ = u.shape
    uf = u.astype(f32).reshape(b_, t_, SSM_GROUPS, SSM_GROUP)
    dt = jnp.exp(log_dt.astype(f32))[:, None]
    ar, ai = a_re.astype(f32), a_im.astype(f32)
    mag = jnp.exp(dt * ar)
    abar_r, abar_i = mag * jnp.cos(dt * ai), mag * jnp.sin(dt * ai)
    den = ar * ar + ai * ai
    nr, ni = abar_r - 1.0, abar_i
    coef_r, coef_i = (nr * ar + ni * ai) / den, (ni * ar - nr * ai) / den
    br, bi = b_re.astype(f32), b_im.astype(f32)
    bbar_r = coef_r[..., None] * br - coef_i[..., None] * bi
    bbar_i = coef_r[..., None] * bi + coef_i[..., None] * br
    bu_r = jnp.einsum('btgc,gnc->btgn', uf, bbar_r)
    bu_i = jnp.einsum('btgc,gnc->btgn', uf, bbar_i)
    shape = bu_r.shape
    elems = (jnp.broadcast_to(abar_r, shape), jnp.broadcast_to(abar_i, shape), bu_r, bu_i)
    _, _, xr, xi = lax.associative_scan(_complex_linear_combine, elems, axis=1)
    y = (jnp.einsum('btgn,gcn->btgc', xr, c_re.astype(f32))
         - jnp.einsum('btgn,gcn->btgc', xi, c_im.astype(f32)))
    y = y.reshape(b_, t_, SSM_W) + d_skip.astype(f32) * uf.reshape(b_, t_, SSM_W)
    y = jax.nn.gelu(y)
    y = y * jax.nn.sigmoid(y @ w_glu.astype(f32) + b_glu.astype(f32))
    return y.astype(u.dtype)


def setup_inputs(seed: int = 0) -> dict:
    key = jax.random.key(seed)
    keys = iter(jax.random.split(key, 64))
    f32 = jnp.float32
    L = DEPTH
    nrm = lambda shape, s: s * jax.random.normal(next(keys), shape, f32)
    uni = lambda shape, lo, hi: jax.random.uniform(next(keys), shape, f32, lo, hi)
    gain = lambda shape: 1.0 + 0.05 * jax.random.normal(next(keys), shape, f32)
    a_im0 = jnp.broadcast_to(jnp.pi * jnp.arange(SSM_STATE, dtype=f32), (L, SSM_GROUPS, SSM_STATE))
    return {
        "x": nrm((BATCH, SEQ, D_MODEL), 1.0),
        "ffn1_pre_g": gain((L, D_MODEL)),
        "ffn1_w_gu": nrm((L, D_MODEL, 2 * D_FF), D_MODEL ** -0.5),
        "ffn1_w_down": nrm((L, D_FF, D_MODEL), D_FF ** -0.5),
        "ffn1_post_g": gain((L, D_MODEL)),
        "mix_pre_g": gain((L, D_MODEL)),
        "w_in": nrm((L, D_MODEL, IN_COLS), D_MODEL ** -0.5),
        "rw_mu": uni((L, RW_COLS), 0.0, 1.0),
        "rw_w0": uni((L, RW_W), -5.0, -0.5),
        "rw_w2": nrm((L, RW_DECAY_LORA, RW_W), 0.1),
        "rw_a0": nrm((L, RW_W), 0.1),
        "rw_a2": nrm((L, RW_AAA_LORA, RW_W), 0.5 * RW_AAA_LORA ** -0.5),
        "rw_g2": nrm((L, RW_GATE_LORA, RW_W), RW_GATE_LORA ** -0.5),
        "rw_k_k": 0.85 + nrm((L, RW_W), 0.05),
        "rw_k_a": 1.0 + nrm((L, RW_W), 0.05),
        "rw_r_k": nrm((L, RW_HEADS, RW_HD), 0.1),
        "rw_gn_w": gain((L, RW_W)),
        "rw_gn_b": nrm((L, RW_W), 0.02),
        "da_lq1": nrm((L, DA_HD), 0.1),
        "da_lk1": nrm((L, DA_HD), 0.1),
        "da_lq2": nrm((L, DA_HD), 0.1),
        "da_lk2": nrm((L, DA_HD), 0.1),
        "da_subln_w": gain((L, 2 * DA_HD)),
        "ssm_a_re": -0.5 + nrm((L, SSM_GROUPS, SSM_STATE), 0.01),
        "ssm_a_im": a_im0 + nrm((L, SSM_GROUPS, SSM_STATE), 0.01),
        "ssm_log_dt": uni((L, SSM_GROUPS), math.log(0.001), math.log(0.1)),
        "ssm_b_re": nrm((L, SSM_GROUPS, SSM_STATE, SSM_GROUP), (0.5 / SSM_GROUP) ** 0.5),
        "ssm_b_im": nrm((L, SSM_GROUPS, SSM_STATE, SSM_GROUP), (0.5 / SSM_GROUP) ** 0.5),
        "ssm_c_re": nrm((L, SSM_GROUPS, SSM_GROUP, SSM_STATE), (1.0 / SSM_STATE) ** 0.5),
        "ssm_c_im": nrm((L, SSM_GROUPS, SSM_GROUP, SSM_STATE), (1.0 / SSM_STATE) ** 0.5),
        "ssm_d": nrm((L, SSM_W), 1.0),
        "ssm_w_glu": nrm((L, SSM_W, SSM_W), SSM_W ** -0.5),
        "ssm_b_glu": nrm((L, SSM_W), 0.02),
        "w_out": nrm((L, D_MIX, D_MODEL), D_MIX ** -0.5),
        "mix_post_g": gain((L, D_MODEL)),
        "ffn2_pre_g": gain((L, D_MODEL)),
        "ffn2_w_gu": nrm((L, D_MODEL, 2 * D_FF), D_MODEL ** -0.5),
        "ffn2_w_down": nrm((L, D_FF, D_MODEL), D_FF ** -0.5),
        "ffn2_post_g": gain((L, D_MODEL)),
    }


def reference(x, ffn1_pre_g, ffn1_w_gu, ffn1_w_down, ffn1_post_g, mix_pre_g, w_in,
              rw_mu, rw_w0, rw_w2, rw_a0, rw_a2, rw_g2, rw_k_k, rw_k_a, rw_r_k, rw_gn_w, rw_gn_b,
              da_lq1, da_lk1, da_lq2, da_lk2, da_subln_w,
              ssm_a_re, ssm_a_im, ssm_log_dt, ssm_b_re, ssm_b_im, ssm_c_re, ssm_c_im, ssm_d,
              ssm_w_glu, ssm_b_glu, w_out, mix_post_g,
              ffn2_pre_g, ffn2_w_gu, ffn2_w_down, ffn2_post_g):
    for l in range(DEPTH):
        h = swiglu(rms_norm(x, ffn1_pre_g[l]), ffn1_w_gu[l], ffn1_w_down[l])
        x = x + 0.5 * rms_norm(h, ffn1_post_g[l])
        z = rms_norm(x, mix_pre_g[l]) @ w_in[l]
        y_rw = rwkv7_mix(z[..., :RW_COLS], rw_mu[l], rw_w0[l], rw_w2[l], rw_a0[l], rw_a2[l],
                         rw_g2[l], rw_k_k[l], rw_k_a[l], rw_r_k[l], rw_gn_w[l], rw_gn_b[l])
        lam_init = 0.8 - 0.6 * math.exp(-0.3 * l)
        y_da = diff_attn_mix(z[..., RW_COLS:RW_COLS + DA_COLS], da_lq1[l], da_lk1[l],
                             da_lq2[l], da_lk2[l], da_subln_w[l], lam_init)
        y_ss = s5_mix(z[..., RW_COLS + DA_COLS:], ssm_a_re[l], ssm_a_im[l], ssm_log_dt[l],
                      ssm_b_re[l], ssm_b_im[l], ssm_c_re[l], ssm_c_im[l], ssm_d[l],
                      ssm_w_glu[l], ssm_b_glu[l])
        y = jnp.concatenate([y_rw, y_da, y_ss], axis=-1) @ w_out[l]
        x = x + rms_norm(y, mix_post_g[l])
        h = swiglu(rms_norm(x, ffn2_pre_g[l]), ffn2_w_gu[l], ffn2_w_down[l])
        x = x + 0.5 * rms_norm(h, ffn2_post_g[l])
    return x
```

```cpp
#include <hip/hip_runtime.h>
#include <hip/hip_cooperative_groups.h>
#include <cstdio>
#include <cstdint>
namespace cg = cooperative_groups;
#ifndef ONE_LAUNCH
#define ONE_LAUNCH 1
#endif
__device__ __forceinline__ int tidx() { int t = threadIdx.x; asm volatile("" : "+v"(t)); return t; }
__device__ __forceinline__ int bidx() { int b = blockIdx.x; asm volatile("" : "+s"(b)); return b; }
namespace pg8 {
#define PG8_LAS __attribute__((address_space(3)))
typedef unsigned short bf16_t;
typedef short bf16x8 __attribute__((ext_vector_type(8)));
typedef float f32x4 __attribute__((ext_vector_type(4)));
typedef unsigned u32x4 __attribute__((ext_vector_type(4)));
constexpr int BM = 256, BK = 64, HALF = 128, HTB = HALF * BK * 2  , STAGE_BYTES = 8 * HTB, NXCD = 8, WGM = 8;

__host__ __device__ __forceinline__ int lds_byte(int r, int c) { const int st = (r >> 4) * 2 + (c >> 5), rr = r & 15, cc = c & 31, ob = rr * 64 + cc * 2; return st * 1024 + (ob ^ (((ob >> 9) & 1) << 5)); }
__host__ __device__ __forceinline__ void stage_rc(int b, int& R, int& C) { const int st = b / 1024, sb = b % 1024, swz = sb ^ (((sb >> 9) & 1) << 5); R = (st >> 1) * 16 + swz / 64; C = (st & 1) * 32 + (swz % 64) / 2; }
__host__ __device__ __forceinline__ int perm32(int rho) { const int n = rho >> 4, i = rho & 15; return 8 * (i >> 2) + 4 * n + (i & 3); }

struct Unit { int pm, pn; };
struct Gemm { const bf16_t* A; const bf16_t* Bt; int M, N, K; };

struct StaticOrder {
    int nM, nN, nwg, G, c;
    __host__ __device__ void init(int M, int N, int G_, int c_) { nM = M / BM; nN = N / BM; nwg = nM * nN; G = G_; c = c_; }
    __host__ __device__ bool next(int i, Unit& u) const {
        const long L = (long)i * G + c; if (L >= nwg) return false;
        int wgid = (int)L; { const int q = nwg / NXCD, r = nwg % NXCD, xcd = wgid % NXCD, off = wgid / NXCD; wgid = (xcd < r ? xcd * (q + 1) : r * (q + 1) + (xcd - r) * q) + off; }
        const int wgm = (nN == 8) ? 4 : WGM;
        const int nig = wgm * nN, gid = wgid / nig, fm = gid * wgm, gsz = (nM - fm) < wgm ? (nM - fm) : wgm;
        u.pm = fm + ((wgid % nig) % gsz); u.pn = (wgid % nig) / gsz; return true;
    }
    __device__ __forceinline__ void a_ready(const Unit&) const {}
    __device__ __forceinline__ void done(const Unit&) const {}
};

__device__ __forceinline__ unsigned cvt_pk_bf16(float lo, float hi) { unsigned r; asm volatile("v_cvt_pk_bf16_f32 %0, %1, %2" : "=v"(r) : "v"(lo), "v"(hi)); return r; }
typedef float f32x2 __attribute__((ext_vector_type(2)));

template <class Epi, class Sched, bool ALIGN_EPI = false, bool SP2 = false>
__device__ __forceinline__ void gemm_phase(PG8_LAS unsigned char* lds, const Gemm g, const Sched& S, const Epi& E) {
    const int tid = tidx(), wid = __builtin_amdgcn_readfirstlane(tid >> 6), lane = tid & 63, wr = wid >> 2, wc = wid & 3, fr = lane & 15, fq = lane >> 4;
    const int K = g.K, nt = K / BK;
    unsigned voffA[2], voffB[2];
#pragma unroll
    for (int i = 0; i < 2; ++i) { int R, C; stage_rc(tid * 16 + i * 8192, R, C); const int Rb = Epi::PERM ? ((R & ~31) + perm32(R & 31)) : R;
        voffA[i] = (unsigned)(R * K + C) * 2u; voffB[i] = (unsigned)(Rb * K + C) * 2u; }
    const size_t kstep = (size_t)(BK * 2);
    const size_t hstep = (size_t)HALF * K * 2;
    const size_t tstep = 2 * hstep;
    const unsigned ldsw = (unsigned)wid * 1024u;
    const int aoff = lds_byte(wr * 64 + fr, fq * 8), boff = lds_byte(wc * 32 + fr, fq * 8);
#define PG8_SA(b, h) (((b) * 2 + (h)) * HTB)
#define PG8_SB(b, h) ((4 + (b) * 2 + (h)) * HTB)
#define PG8_STAGE(bufoff, gbase, voff) do { _Pragma("unroll") for (int _i = 0; _i < 2; ++_i) \
        __builtin_amdgcn_global_load_lds((const unsigned*)((const char*)(gbase) + (voff)[_i]), (PG8_LAS unsigned*)(lds + (bufoff) + ldsw + _i * 8192), 16, 0, 0); } while (0)
#define PG8_LDA(dst, b, h) do { _Pragma("unroll") for (int m = 0; m < 4; ++m) _Pragma("unroll") for (int k = 0; k < 2; ++k) dst[m][k] = *(const PG8_LAS bf16x8*)(lds + PG8_SA(b, h) + aoff + m * 2048 + k * 1024); } while (0)
#define PG8_LDB(dst, b, h) do { _Pragma("unroll") for (int n = 0; n < 2; ++n) _Pragma("unroll") for (int k = 0; k < 2; ++k) dst[n][k] = *(const PG8_LAS bf16x8*)(lds + PG8_SB(b, h) + boff + n * 2048 + k * 1024); } while (0)
#define PG8_MMA(ai, bj, At, Bt) do { __builtin_amdgcn_s_setprio(1); _Pragma("unroll") for (int m = 0; m < 4; ++m) _Pragma("unroll") for (int n = 0; n < 2; ++n) _Pragma("unroll") for (int k = 0; k < 2; ++k) \
        acc[ai][bj][m][n] = __builtin_amdgcn_mfma_f32_16x16x32_bf16(Bt[n][k], At[m][k], acc[ai][bj][m][n], 0, 0, 0); __builtin_amdgcn_s_setprio(0); } while (0)
#define PG8_WAIT_V(n) asm volatile("s_waitcnt vmcnt(" #n ")" ::: "memory")
#define PG8_WAIT_L(n) asm volatile("s_waitcnt lgkmcnt(" #n ")" ::: "memory")
#define PG8_BAR __builtin_amdgcn_s_barrier()
#define PG8_SCHED __builtin_amdgcn_sched_barrier(0)
    Unit cur, nxt; int ui = 0;
    if (!S.next(0, cur)) return;
    f32x4 acc[2][2][4][2];
#pragma unroll
    for (int a = 0; a < 2; ++a)
#pragma unroll
        for (int b = 0; b < 2; ++b)
#pragma unroll
            for (int m = 0; m < 4; ++m)
#pragma unroll
                for (int n = 0; n < 2; ++n) acc[a][b][m][n] = (f32x4){0.f, 0.f, 0.f, 0.f};
    bf16x8 At[4][2], B0[2][2], B1[2][2];
    const char* cA = (const char*)g.A + (size_t)cur.pm * tstep; const char* cB = (const char*)g.Bt + (size_t)cur.pn * tstep;
    S.a_ready(cur);
    if constexpr (SP2) {
        PG8_STAGE(PG8_SB(0, 0), cB, voffB); PG8_STAGE(PG8_SB(0, 1), cB + hstep, voffB); PG8_STAGE(PG8_SA(0, 0), cA, voffA); PG8_STAGE(PG8_SA(0, 1), cA + hstep, voffA);
        if (wr == 1) PG8_BAR;
        PG8_WAIT_V(2); PG8_BAR;
        PG8_STAGE(PG8_SB(1, 0), cB + kstep, voffB); PG8_STAGE(PG8_SA(1, 0), cA + kstep, voffA); PG8_STAGE(PG8_SB(1, 1), cB + hstep + kstep, voffB);
        PG8_WAIT_V(6); PG8_BAR;
    } else {
        PG8_STAGE(PG8_SB(0, 0), cB, voffB); PG8_STAGE(PG8_SA(0, 0), cA, voffA); PG8_STAGE(PG8_SB(0, 1), cB + hstep, voffB); PG8_STAGE(PG8_SA(0, 1), cA + hstep, voffA);
        if (wr == 1) PG8_BAR;
        PG8_WAIT_V(4); PG8_BAR;
        PG8_STAGE(PG8_SB(1, 0), cB + kstep, voffB); PG8_STAGE(PG8_SA(1, 0), cA + kstep, voffA); PG8_STAGE(PG8_SB(1, 1), cB + hstep + kstep, voffB);
        PG8_WAIT_V(6); PG8_BAR;
    }
    for (;;) {
        const bool has_next = S.next(ui + 1, nxt);
        const char* nA = has_next ? (const char*)g.A + (size_t)nxt.pm * tstep : cA; const char* nB = has_next ? (const char*)g.Bt + (size_t)nxt.pn * tstep : cB;
        for (int t = 0; t < nt; t += 2) {
            const bool last = (t == nt - 2);
            const char* a1 = cA + (size_t)(t + 1) * kstep;
            const char* a2 = last ? nA : cA + (size_t)(t + 2) * kstep; const char* b2 = last ? nB : cB + (size_t)(t + 2) * kstep;
            const char* a3 = a2 + kstep; const char* b3 = b2 + kstep;
            if (last && has_next) S.a_ready(nxt);
            if constexpr (SP2) {
            PG8_LDB(B0, 0, 0); PG8_LDB(B1, 0, 1); PG8_SCHED; PG8_LDA(At, 0, 0); PG8_STAGE(PG8_SA(1, 1), a1 + hstep, voffA);
            PG8_WAIT_V(8); PG8_WAIT_L(0); PG8_BAR; PG8_MMA(0, 0, At, B0); PG8_MMA(0, 1, At, B1); PG8_BAR; PG8_SCHED;
            PG8_LDA(At, 0, 1); PG8_STAGE(PG8_SB(0, 0), b2, voffB); PG8_STAGE(PG8_SB(0, 1), b2 + hstep, voffB); PG8_STAGE(PG8_SA(0, 0), a2, voffA);
            PG8_WAIT_V(8); PG8_WAIT_L(0); PG8_BAR; PG8_MMA(1, 0, At, B0); PG8_MMA(1, 1, At, B1); PG8_BAR; PG8_SCHED;
            PG8_LDB(B0, 1, 0); PG8_LDB(B1, 1, 1); PG8_SCHED; PG8_LDA(At, 1, 0); PG8_STAGE(PG8_SA(0, 1), a2 + hstep, voffA);
            PG8_WAIT_V(8); PG8_WAIT_L(0); PG8_BAR; PG8_MMA(0, 0, At, B0); PG8_MMA(0, 1, At, B1); PG8_BAR; PG8_SCHED;
            PG8_LDA(At, 1, 1); PG8_STAGE(PG8_SB(1, 0), b3, voffB); PG8_STAGE(PG8_SB(1, 1), b3 + hstep, voffB); PG8_STAGE(PG8_SA(1, 0), a3, voffA);
            PG8_WAIT_V(8); PG8_WAIT_L(0); PG8_BAR; PG8_MMA(1, 0, At, B0); PG8_MMA(1, 1, At, B1); PG8_BAR; PG8_SCHED;
            } else {
            PG8_LDB(B0, 0, 0); PG8_SCHED; PG8_LDA(At, 0, 0); PG8_STAGE(PG8_SA(1, 1), a1 + hstep, voffA);
            PG8_WAIT_L(8); PG8_BAR; PG8_WAIT_L(0); PG8_MMA(0, 0, At, B0); PG8_BAR; PG8_SCHED;
            PG8_LDB(B1, 0, 1); PG8_STAGE(PG8_SB(0, 0), b2, voffB);
            PG8_BAR; PG8_WAIT_L(0); PG8_MMA(0, 1, At, B1); PG8_BAR;
            PG8_LDA(At, 0, 1); PG8_STAGE(PG8_SA(0, 0), a2, voffA);
            PG8_BAR; PG8_WAIT_L(0); PG8_MMA(1, 0, At, B0); PG8_BAR; PG8_SCHED;
            PG8_STAGE(PG8_SB(0, 1), b2 + hstep, voffB);
            PG8_WAIT_V(6); PG8_BAR; PG8_MMA(1, 1, At, B1); PG8_BAR;
            PG8_LDB(B0, 1, 0); PG8_SCHED; PG8_LDA(At, 1, 0); PG8_STAGE(PG8_SA(0, 1), a2 + hstep, voffA);
            PG8_WAIT_L(8); PG8_BAR; PG8_WAIT_L(0); PG8_MMA(0, 0, At, B0); PG8_BAR; PG8_SCHED;
            PG8_LDB(B1, 1, 1); PG8_STAGE(PG8_SB(1, 0), b3, voffB);
            PG8_BAR; PG8_WAIT_L(0); PG8_MMA(0, 1, At, B1); PG8_BAR;
            PG8_LDA(At, 1, 1); PG8_STAGE(PG8_SA(1, 0), a3, voffA);
            PG8_BAR; PG8_WAIT_L(0); PG8_MMA(1, 0, At, B0); PG8_BAR; PG8_SCHED;
            PG8_STAGE(PG8_SB(1, 1), b3 + hstep, voffB);
            PG8_WAIT_V(6); PG8_BAR; PG8_MMA(1, 1, At, B1); PG8_BAR;
            }
        }
        if constexpr (ALIGN_EPI) { if (wr == 0) PG8_BAR; }
        if constexpr (!Epi::AFTER_DRAIN) { E(acc, cur, wr, wc, fr, fq); S.done(cur); }
        if (!has_next) break;
#pragma unroll
        for (int a = 0; a < 2; ++a)
#pragma unroll
            for (int b = 0; b < 2; ++b)
#pragma unroll
                for (int m = 0; m < 4; ++m)
#pragma unroll
                    for (int n = 0; n < 2; ++n) acc[a][b][m][n] = (f32x4){0.f, 0.f, 0.f, 0.f};
        cur = nxt; cA = nA; cB = nB; ++ui;
        if constexpr (ALIGN_EPI) { if (wr == 1) PG8_BAR; }
    }
    PG8_WAIT_V(0);
    if constexpr (!ALIGN_EPI) { if (wr == 0) PG8_BAR; }
    PG8_BAR;
    if constexpr (Epi::AFTER_DRAIN) { E.fused(acc, cur, wr, wc, fr, fq, lds, wid, lane); S.done(cur); }
#undef PG8_SA
#undef PG8_SB
#undef PG8_STAGE
#undef PG8_LDA
#undef PG8_LDB
#undef PG8_MMA
#undef PG8_WAIT_V
#undef PG8_WAIT_L
#undef PG8_BAR
#undef PG8_SCHED
}
}
using pg8::bf16_t; using pg8::bf16x8; using pg8::f32x4; using pg8::u32x4; using pg8::Unit; using pg8::cvt_pk_bf16;
#define LAS __attribute__((address_space(3)))
typedef float f32x2 __attribute__((ext_vector_type(2)));
typedef unsigned u32x2 __attribute__((ext_vector_type(2)));
typedef short bf16x4 __attribute__((ext_vector_type(4)));
#define WAVE_SYNC() asm volatile("s_waitcnt lgkmcnt(0)" ::: "memory")

constexpr int MT = 8192, SEQ = 4096, DM = 2048, FF = 5504, INC = 5376, RWC = 2560;
constexpr int NPL = 16, NPH = 1 + 2 * NPL;
constexpr int LDS_BYTES = 147456;
constexpr size_t MiB = 1u << 20;
constexpr size_t SZ_WGU = (size_t)11008 * 2048 * 2, SZ_WD = (size_t)2048 * 5504 * 2, SZ_WIN = (size_t)5376 * 2048 * 2, SZ_WOUT = (size_t)2048 * 2048 * 2;
constexpr size_t SZ_WLORA = (size_t)2304 * 256 * 2, SZ_WGLU = (size_t)512 * 512 * 2, SZ_S5TAB = (size_t)(32 * 64 * 2 + 32 * 64 * 32) * 4;
constexpr size_t WS_WGU = 1 * MiB;
constexpr size_t WS_WD = WS_WGU + 4 * SZ_WGU;
constexpr size_t WS_WIN = WS_WD + 4 * SZ_WD;
constexpr size_t WS_WOUT = WS_WIN + 2 * SZ_WIN;
constexpr size_t WS_WLORA = WS_WOUT + 2 * SZ_WOUT;
constexpr size_t WS_WGLU = WS_WLORA + 2 * SZ_WLORA;
constexpr size_t WS_S5TAB = WS_WGLU + 2 * SZ_WGLU;
constexpr size_t WS_XB = ((WS_S5TAB + 2 * SZ_S5TAB + MiB - 1) / MiB) * MiB;
constexpr size_t WS_RS = WS_XB + 32 * MiB;
constexpr size_t WS_YCAT = WS_RS + 1 * MiB;
constexpr size_t WS_BIG = WS_YCAT + 32 * MiB;
constexpr size_t WS_ACT = WS_BIG, WS_H = WS_BIG + 96 * MiB;
constexpr size_t WS_ZR = WS_BIG, WS_DAQK = WS_BIG + 80 * MiB, WS_VT = WS_BIG + 104 * MiB, WS_ZS = WS_BIG + 116 * MiB, WS_LA = WS_BIG + 132 * MiB;
constexpr size_t WS_LR = WS_BIG + 136 * MiB, WS_SEND = WS_BIG + 208 * MiB, WS_SIN = WS_BIG + 232 * MiB;
constexpr size_t WS_YS = WS_BIG + 244 * MiB, WS_YSB = WS_BIG + 260 * MiB, WS_XE = WS_BIG + 268 * MiB, WS_XIN = WS_BIG + 269 * MiB;
constexpr size_t WS_YL = WS_BIG + 172 * MiB, WS_BON = WS_BIG + 196 * MiB, WS_QQ = WS_BIG + 270 * MiB, WS_END = WS_BIG + 294 * MiB;
static_assert(WS_END <= 700 * MiB, "workspace budget");

struct Params { const float* in[39]; float* out; unsigned char* ws; int ph_lo, ph_hi; };

#define DPPF(v, ctrl) __builtin_bit_cast(float, __builtin_amdgcn_mov_dpp(__builtin_bit_cast(int, (v)), (ctrl), 0xf, 0xf, true))
__device__ __forceinline__ float wave_sum(float v) {
    v += DPPF(v, 0xB1); v += DPPF(v, 0x4E); v += DPPF(v, 0x124); v += DPPF(v, 0x128);
    const float r0 = __builtin_bit_cast(float, __builtin_amdgcn_readlane(__builtin_bit_cast(int, v), 0)), r1 = __builtin_bit_cast(float, __builtin_amdgcn_readlane(__builtin_bit_cast(int, v), 16));
    const float r2 = __builtin_bit_cast(float, __builtin_amdgcn_readlane(__builtin_bit_cast(int, v), 32)), r3 = __builtin_bit_cast(float, __builtin_amdgcn_readlane(__builtin_bit_cast(int, v), 48));
    return (r0 + r1) + (r2 + r3);
}
__device__ __forceinline__ float sigmoidf_(float x) { return __builtin_amdgcn_rcpf(1.0f + __expf(-x)); }
__device__ __forceinline__ float dot4(f32x4 a, f32x4 b) { return (a.x * b.x + a.y * b.y) + (a.z * b.z + a.w * b.w); }

struct EpiGU {
    static constexpr bool PERM = true, AFTER_DRAIN = false;
    bf16_t* ACT; const float* rs;
    __device__ __forceinline__ void operator()(const f32x4 (&acc)[2][2][4][2], const Unit& u, int wr, int wc, int fr, int fq) const {
        const int row0 = u.pm * 256 + wr * 64 + fr, col0 = u.pn * 128 + wc * 32 + fq * 8;
#pragma unroll
        for (int ai = 0; ai < 2; ++ai)
#pragma unroll
            for (int m = 0; m < 4; ++m) {
                const int row = row0 + ai * 128 + m * 16; const float s = rs[row];
                const float ns = -1.4426950408889634f * s, s2 = s * s; const f32x2 ns2 = {ns, ns}, ss2 = {s2, s2}, one2 = {1.f, 1.f};
                float o[8];
#pragma unroll
                for (int n = 0; n < 2; ++n)
#pragma unroll
                    for (int j = 0; j < 4; j += 2) {
                        const f32x2 g2 = {acc[ai][0][m][n][j], acc[ai][0][m][n][j + 1]}, u2 = {acc[ai][1][m][n][j], acc[ai][1][m][n][j + 1]};
                        const f32x2 a2 = g2 * ns2; f32x2 d2 = {__builtin_amdgcn_exp2f(a2.x), __builtin_amdgcn_exp2f(a2.y)}; d2 = d2 + one2;
                        const f32x2 r2 = {__builtin_amdgcn_rcpf(d2.x), __builtin_amdgcn_rcpf(d2.y)};
                        const f32x2 o2 = (g2 * u2) * (ss2 * r2);
                        o[n * 4 + j] = o2.x; o[n * 4 + j + 1] = o2.y; }
                u32x4 w; w.x = cvt_pk_bf16(o[0], o[1]); w.y = cvt_pk_bf16(o[2], o[3]); w.z = cvt_pk_bf16(o[4], o[5]); w.w = cvt_pk_bf16(o[6], o[7]);
                *(u32x4*)(ACT + (size_t)row * FF + col0) = w;
            }
    }
};
#define BF2F(x) __builtin_bit_cast(float, ((unsigned)(x)) << 16)
struct EpiBF {
    static constexpr bool PERM = true, AFTER_DRAIN = false;
    bf16_t* C; int ldc;
    __device__ __forceinline__ void operator()(const f32x4 (&acc)[2][2][4][2], const Unit& u, int wr, int wc, int fr, int fq) const {
        const int row0 = u.pm * 256 + wr * 64 + fr, col0 = u.pn * 256 + wc * 32 + fq * 8;
#pragma unroll
        for (int ai = 0; ai < 2; ++ai)
#pragma unroll
            for (int m = 0; m < 4; ++m)
#pragma unroll
                for (int bj = 0; bj < 2; ++bj) {
                    const f32x4 v0 = acc[ai][bj][m][0], v1 = acc[ai][bj][m][1];
                    u32x4 w; w.x = cvt_pk_bf16(v0[0], v0[1]); w.y = cvt_pk_bf16(v0[2], v0[3]); w.z = cvt_pk_bf16(v1[0], v1[1]); w.w = cvt_pk_bf16(v1[2], v1[3]);
                    *(u32x4*)(C + (size_t)(row0 + ai * 128 + m * 16) * ldc + col0 + bj * 128) = w;
                }
    }
};
struct EpiIN {
    static constexpr bool PERM = true, AFTER_DRAIN = false;
    float* ZR; bf16_t* DAQK; bf16_t* VT; float* ZS; const float* rs;
    __device__ __forceinline__ void operator()(const f32x4 (&acc)[2][2][4][2], const Unit& u, int wr, int wc, int fr, int fq) const {
        const int row0 = u.pm * 256 + wr * 64 + fr, cl0 = wc * 32 + fq * 8; const int pn = u.pn;
#pragma unroll
        for (int ai = 0; ai < 2; ++ai)
#pragma unroll
            for (int m = 0; m < 4; ++m) {
                const int row = row0 + ai * 128 + m * 16; const float s = rs[row];
#pragma unroll
                for (int bj = 0; bj < 2; ++bj) {
                    const f32x4 v0 = acc[ai][bj][m][0] * s, v1 = acc[ai][bj][m][1] * s; const int cl = cl0 + bj * 128;
                    if (pn < 10) { float* p = ZR + (size_t)row * RWC + pn * 256 + cl; *(f32x4*)p = v0; *(f32x4*)(p + 4) = v1; }
                    else if (pn < 16) { const float sc = (pn < 13) ? 0.18033688011112042f : 1.0f;
                        u32x4 w; w.x = cvt_pk_bf16(v0[0] * sc, v0[1] * sc); w.y = cvt_pk_bf16(v0[2] * sc, v0[3] * sc); w.z = cvt_pk_bf16(v1[0] * sc, v1[1] * sc); w.w = cvt_pk_bf16(v1[2] * sc, v1[3] * sc);
                        *(u32x4*)(DAQK + (size_t)row * 1536 + (pn - 10) * 256 + cl) = w; }
                    else if (pn < 19) { const int b = row >> 12, t = row & 4095; bf16_t* p = VT + ((size_t)(b * 768 + (pn - 16) * 256 + cl)) * SEQ + t;
#pragma unroll
                        for (int j = 0; j < 4; ++j) { p[(size_t)j * SEQ] = (bf16_t)(cvt_pk_bf16(v0[j], 0.f) & 0xffffu); p[(size_t)(j + 4) * SEQ] = (bf16_t)(cvt_pk_bf16(v1[j], 0.f) & 0xffffu); } }
                    else { float* p = ZS + (size_t)row * 512 + (pn - 19) * 256 + cl; *(f32x4*)p = v0; *(f32x4*)(p + 4) = v1; }
                }
            }
    }
};
__device__ __forceinline__ float decay_of(float x) {
    return __expf(-0.6065306597126334f * sigmoidf_(x));
}
struct EpiGLU {
    static constexpr bool PERM = true, AFTER_DRAIN = false;
    bf16_t* YCAT; const float* YS; const float* bglu;
    __device__ __forceinline__ void operator()(const f32x4 (&acc)[2][2][4][2], const Unit& u, int wr, int wc, int fr, int fq) const {
        const int row0 = u.pm * 256 + wr * 64 + fr, col0 = u.pn * 256 + wc * 32 + fq * 8;
#pragma unroll
        for (int bj = 0; bj < 2; ++bj) {
            const int c = col0 + bj * 128;
            const f32x4 b0 = *(const f32x4*)(bglu + c), b1 = *(const f32x4*)(bglu + c + 4);
#pragma unroll
            for (int ai = 0; ai < 2; ++ai)
#pragma unroll
                for (int m = 0; m < 4; ++m) {
                    const int row = row0 + ai * 128 + m * 16;
                    const f32x4 y0 = *(const f32x4*)(YS + (size_t)row * 512 + c), y1 = *(const f32x4*)(YS + (size_t)row * 512 + c + 4);
                    const f32x4 a0 = acc[ai][bj][m][0] + b0, a1 = acc[ai][bj][m][1] + b1;
                    float o[8];
#pragma unroll
                    for (int j = 0; j < 4; ++j) { o[j] = y0[j] * sigmoidf_(a0[j]); o[4 + j] = y1[j] * sigmoidf_(a1[j]); }
                    u32x4 w; w.x = cvt_pk_bf16(o[0], o[1]); w.y = cvt_pk_bf16(o[2], o[3]); w.z = cvt_pk_bf16(o[4], o[5]); w.w = cvt_pk_bf16(o[6], o[7]);
                    *(u32x4*)(YCAT + (size_t)row * DM + 1536 + c) = w;
                }
        }
    }
};
__device__ __forceinline__ void transpose_tile(const float* src, int ld, int K, const float* gvec, bf16_t* dst, int kt, int nt, int mode, LAS float* tl) {
    const int tid = tidx(); const int k0 = kt * 128, n0 = nt * 256;
    f32x4 v[16];
    const int j = (tid & 63) * 4; const int sc = (mode == 1) ? ((j < 128) ? nt * 128 + j : FF + nt * 128 + j - 128) : n0 + j;
    const float* sp = src + (size_t)(k0 + (tid >> 6)) * ld + sc;
#pragma unroll
    for (int i = 0; i < 16; ++i) v[i] = *(const f32x4*)(sp + (size_t)(8 * i) * ld);
#pragma unroll
    for (int i = 0; i < 16; ++i) {
        const int row = (tid >> 6) + 8 * i;
        const float g = gvec ? gvec[k0 + row] : 1.f;
        const int sw = ((row >> 3) & 15) << 1; LAS float* q = tl + row * 256;
        q[(j) ^ sw] = v[i].x * g; q[(j + 1) ^ sw] = v[i].y * g; q[(j + 2) ^ sw] = v[i].z * g; q[(j + 3) ^ sw] = v[i].w * g;
    }
    __syncthreads();
#pragma unroll
    for (int jj = 0; jj < 8; ++jj) {
        const int c = tid + 512 * jj; const int n = c >> 4, kc = c & 15;
        float x[8];
#pragma unroll
        for (int i = 0; i < 8; ++i) x[i] = tl[(kc * 8 + i) * 256 + (n ^ (kc << 1))];
        u32x4 w; w.x = cvt_pk_bf16(x[0], x[1]); w.y = cvt_pk_bf16(x[2], x[3]); w.z = cvt_pk_bf16(x[4], x[5]); w.w = cvt_pk_bf16(x[6], x[7]);
        *(u32x4*)(dst + (size_t)(n0 + n) * K + k0 + kc * 8) = w;
    }
    __syncthreads();
}

__device__ __forceinline__ void row_phase(const bf16_t* H, const float* xin, float* Xout, bf16_t* XB, float* RS, const float* g, float c, int wave, int lane, int m_begin = -1, int m_count = 0) {
    const int mb = (m_begin < 0) ? bidx() * 8 + wave : m_begin + wave, me = (m_begin < 0) ? MT : m_begin + m_count, mstep = (m_begin < 0) ? gridDim.x * 8 : 8;
#define BFX4(w) (f32x4){__builtin_bit_cast(float, (w).x << 16), __builtin_bit_cast(float, (w).x & 0xffff0000u), __builtin_bit_cast(float, (w).y << 16), __builtin_bit_cast(float, (w).y & 0xffff0000u)}
    if (H) {
        for (int m = mb; m < me; m += 2 * mstep) {
            const int m2 = (m + mstep < me) ? m + mstep : m;
            u32x2 hw[2][8], xw[2][8];
#pragma unroll
            for (int i = 0; i < 8; ++i) { const int o = (lane + 64 * i) * 4;
                hw[0][i] = *(const u32x2*)(H + (size_t)m * DM + o); xw[0][i] = *(const u32x2*)(XB + (size_t)m * DM + o);
                hw[1][i] = *(const u32x2*)(H + (size_t)m2 * DM + o); xw[1][i] = *(const u32x2*)(XB + (size_t)m2 * DM + o); }
#pragma unroll
            for (int r = 0; r < 2; ++r) {
                const int mr = r ? m2 : m;
                if (r == 1 && m2 == m) break;
                float ss = 0.f;
#pragma unroll
                for (int i = 0; i < 8; ++i) { const f32x4 hh = BFX4(hw[r][i]); ss += dot4(hh, hh); }
                ss = wave_sum(ss); const float rstd = rsqrtf(ss * (1.0f / DM) + 1e-6f) * c;
                float s2 = 0.f;
#pragma unroll
                for (int i = 0; i < 8; ++i) {
                    const size_t o = (size_t)mr * DM + (lane + 64 * i) * 4;
                    const f32x4 hh = BFX4(hw[r][i]); f32x4 x = BFX4(xw[r][i]);
                    const f32x4 gg = *(const f32x4*)(g + (lane + 64 * i) * 4); x = x + hh * rstd * gg;
                    if (Xout) *(f32x4*)(Xout + o) = x;
                    s2 += dot4(x, x);
                    u32x2 w; w.x = cvt_pk_bf16(x.x, x.y); w.y = cvt_pk_bf16(x.z, x.w); *(u32x2*)(XB + o) = w;
                }
                s2 = wave_sum(s2);
                if (lane == 0) RS[mr] = rsqrtf(s2 * (1.0f / DM) + 1e-6f);
            }
        }
    } else {
        for (int m = mb; m < me; m += mstep) {
            float s2 = 0.f;
#pragma unroll
            for (int i = 0; i < 8; ++i) {
                const size_t o = (size_t)m * DM + (lane + 64 * i) * 4;
                const f32x4 x = *(const f32x4*)(xin + o);
                if (Xout) *(f32x4*)(Xout + o) = x;
                s2 += dot4(x, x);
                u32x2 w; w.x = cvt_pk_bf16(x.x, x.y); w.y = cvt_pk_bf16(x.z, x.w); *(u32x2*)(XB + o) = w;
            }
            s2 = wave_sum(s2);
            if (lane == 0) RS[m] = rsqrtf(s2 * (1.0f / DM) + 1e-6f);
        }
    }
#undef BFX4
}

__device__ __forceinline__ void weight_tile(const Params& p, int gt, LAS unsigned char* lds) {
    unsigned char* ws = p.ws;
    const int l = gt / 2536; int r = gt - l * 2536;
    const float* src; int ld, K, ntn, mode = 0; const float* gv = nullptr; bf16_t* dst;
    if (r < 1376) { const int which = r >= 688; r -= which * 688; src = p.in[which ? 36 : 2] + (size_t)l * DM * 2 * FF; ld = 2 * FF; K = DM; ntn = 43; mode = 1; gv = p.in[which ? 35 : 1] + l * DM; dst = (bf16_t*)(ws + WS_WGU + (size_t)(l * 2 + which) * SZ_WGU); }
    else if (r < 2064) { r -= 1376; const int which = r >= 344; r -= which * 344; src = p.in[which ? 37 : 3] + (size_t)l * FF * DM; ld = DM; K = FF; ntn = 8; dst = (bf16_t*)(ws + WS_WD + (size_t)(l * 2 + which) * SZ_WD); }
    else if (r < 2400) { r -= 2064; src = p.in[6] + (size_t)l * DM * INC; ld = INC; K = DM; ntn = 21; gv = p.in[5] + l * DM; dst = (bf16_t*)(ws + WS_WIN + (size_t)l * SZ_WIN); }
    else if (r < 2528) { r -= 2400; src = p.in[33] + (size_t)l * DM * DM; ld = DM; K = DM; ntn = 8; dst = (bf16_t*)(ws + WS_WOUT + (size_t)l * SZ_WOUT); }
    else { r -= 2528; src = p.in[31] + (size_t)l * 512 * 512; ld = 512; K = 512; ntn = 2; dst = (bf16_t*)(ws + WS_WGLU + (size_t)l * SZ_WGLU); }
    const int kt = r / ntn, nt = r - kt * ntn;
    transpose_tile(src, ld, K, gv, dst, kt, nt, mode, (LAS float*)lds);
}

__device__ __forceinline__ void prologue(const Params& p, LAS unsigned char* lds, int wave, int lane) {
    unsigned char* ws = p.ws; const int tid = tidx(); const int G = gridDim.x;
    for (int gt = bidx(); gt < 2 * 2536 - 1376; gt += G) weight_tile(p, (gt < 2536) ? gt : gt + 1376, lds);
    if (bidx() == 0) ((unsigned*)ws)[tid] = 0u;
    for (int idx = bidx() * 512 + tid; idx < 2 * 2304 * 256; idx += G * 512) {
        const int l = idx / (2304 * 256); const int r = idx - l * (2304 * 256); const int n = r >> 8, k = r & 255;
        float v = 0.f;
        if (n < 768) { if (k < 64) v = p.in[9][((size_t)l * 64 + k) * 768 + n]; }
        else if (n < 1536) { if (k >= 64 && k < 128) v = p.in[11][((size_t)l * 64 + (k - 64)) * 768 + (n - 768)]; }
        else { if (k >= 128) v = p.in[12][((size_t)l * 128 + (k - 128)) * 768 + (n - 1536)]; }
        ((bf16_t*)(ws + WS_WLORA))[idx] = (bf16_t)(cvt_pk_bf16(v, 0.f) & 0xffffu);
    }
    for (int idx = bidx() * 512 + tid; idx < 2 * 2048; idx += G * 512) {
        const int l = idx >> 11, gn = idx & 2047, g = gn >> 6;
        float* tab = (float*)(ws + WS_S5TAB + (size_t)l * SZ_S5TAB);
        const float dt = expf(p.in[25][l * 32 + g]); const float ar = p.in[23][l * 2048 + gn], ai = p.in[24][l * 2048 + gn];
        const float mag = expf(dt * ar); const float abr = mag * cosf(dt * ai), abi = mag * sinf(dt * ai);
        const float den = ar * ar + ai * ai; const float nr = abr - 1.0f, ni = abi;
        const float cr = (nr * ar + ni * ai) / den, ci = (ni * ar - nr * ai) / den;
        tab[gn * 2] = abr; tab[gn * 2 + 1] = abi;
        const float* br = p.in[26] + ((size_t)l * 2048 + gn) * 16; const float* bi = p.in[27] + ((size_t)l * 2048 + gn) * 16;
#pragma unroll
        for (int c = 0; c < 16; ++c) { tab[4096 + gn * 32 + c * 2] = cr * br[c] - ci * bi[c]; tab[4096 + gn * 32 + c * 2 + 1] = cr * bi[c] + ci * br[c]; }
    }
    row_phase(nullptr, p.in[0], nullptr, (bf16_t*)(ws + WS_XB), (float*)(ws + WS_RS), nullptr, 0.f, wave, lane);
}

__device__ __forceinline__ void la_prep(const Params& p, int l) {
    const float* ZR = (const float*)(p.ws + WS_ZR); bf16_t* LA = (bf16_t*)(p.ws + WS_LA); const float* mu = p.in[7] + l * RWC;
    for (int idx = bidx() * 512 + tidx(); idx < MT * 64; idx += gridDim.x * 512) {
        const int m = idx >> 6, c4 = (idx & 63) * 4; const int col = 2304 + c4;
        const f32x4 zc = *(const f32x4*)(ZR + (size_t)m * RWC + col);
        f32x4 zp = {0.f, 0.f, 0.f, 0.f}; if (m & (SEQ - 1)) zp = *(const f32x4*)(ZR + (size_t)(m - 1) * RWC + col);
        const f32x4 m4 = *(const f32x4*)(mu + col);
        f32x4 z = zc + (zp - zc) * m4;
        if (c4 < 64) { z.x = tanhf(z.x); z.y = tanhf(z.y); z.z = tanhf(z.z); z.w = tanhf(z.w); }
        else if (c4 >= 128) { z.x = sigmoidf_(z.x); z.y = sigmoidf_(z.y); z.z = sigmoidf_(z.z); z.w = sigmoidf_(z.w); }
        u32x2 w; w.x = cvt_pk_bf16(z.x, z.y); w.y = cvt_pk_bf16(z.z, z.w);
        *(u32x2*)(LA + (size_t)m * 256 + c4) = w;
    }
}

__device__ __forceinline__ float gelu_tanh(float x) { const float t = tanhf(0.7978845608028654f * (x + 0.044715f * x * x * x)); return 0.5f * x * (1.0f + t); }

template <int PASS>
__device__ __forceinline__ void s5_scan(const Params& p, int l, int widx, int nw, int beff, int nblk, int lane, LAS unsigned char* lds) {
    if (widx < 0 || widx >= nw || beff < 0) return;
    unsigned char* ws = p.ws;
    LAS float* ub = (LAS float*)(lds + widx * 19456);
    LAS float* xb = ub + 512;
    LAS float* ct = xb + 16 * 132;
    const float* ZS = (const float*)(ws + WS_ZS); const float* tab = (const float*)(ws + WS_S5TAB + (size_t)l * SZ_S5TAB);
    float* XE = (float*)(ws + WS_XE);
    float* YS = (float*)(ws + WS_YS); bf16_t* YSB = (bf16_t*)(ws + WS_YSB);
    for (int u = widx * nblk + beff; u < 1024; u += nw * nblk) {
        const int c = u & 15, g = (u >> 4) & 31, b = u >> 9; const int gn = g * 64 + lane;
        const float ar = tab[gn * 2], ai = tab[gn * 2 + 1];
        float br[16], bi[16];
#pragma unroll
        for (int q = 0; q < 8; ++q) { const f32x4 v = *(const f32x4*)(tab + 4096 + gn * 32 + q * 4); br[2 * q] = v.x; bi[2 * q] = v.y; br[2 * q + 1] = v.z; bi[2 * q + 1] = v.w; }
        float xr = 0.f, xi = 0.f;
        if (PASS == 2) {
            float pr = ar, pi = ai;
#pragma unroll
            for (int i = 0; i < 8; ++i) { const float r2 = pr * pr - pi * pi, i2 = 2.f * pr * pi; pr = r2; pi = i2; }
            for (int cp = 0; cp < c; ++cp) { const int up = (u & ~15) + cp; const float er = XE[(up * 64 + lane) * 2], ei = XE[(up * 64 + lane) * 2 + 1];
                const float nr = pr * xr - pi * xi + er, ni = pr * xi + pi * xr + ei; xr = nr; xi = ni; }
#pragma unroll
            for (int cc = 0; cc < 16; ++cc) { ct[cc * 132 + lane] = p.in[28][((size_t)l * 32 + g) * 1024 + cc * 64 + lane]; ct[cc * 132 + 64 + lane] = -p.in[29][((size_t)l * 32 + g) * 1024 + cc * 64 + lane]; }
        }
        const int m0 = b * SEQ + c * 256;
        f32x4 un = *(const f32x4*)(ZS + (size_t)(m0 + (lane >> 2)) * 512 + g * 16 + (lane & 3) * 4);
        for (int bt = 0; bt < 16; ++bt) {
            LAS float* ubc = ub + (bt & 1) * 256;
            *(LAS f32x4*)(ubc + lane * 4) = un;
            if (bt + 1 < 16) un = *(const f32x4*)(ZS + (size_t)(m0 + (bt + 1) * 16 + (lane >> 2)) * 512 + g * 16 + (lane & 3) * 4);
            WAVE_SYNC();
#pragma unroll 4
            for (int s = 0; s < 16; ++s) {
                const f32x4 u0 = *(LAS f32x4*)(ubc + s * 16), u1 = *(LAS f32x4*)(ubc + s * 16 + 4), u2 = *(LAS f32x4*)(ubc + s * 16 + 8), u3 = *(LAS f32x4*)(ubc + s * 16 + 12);
                float bur = 0.f, bui = 0.f;
#pragma unroll
                for (int j = 0; j < 4; ++j) { bur += br[j] * u0[j]; bui += bi[j] * u0[j]; }
#pragma unroll
                for (int j = 0; j < 4; ++j) { bur += br[4 + j] * u1[j]; bui += bi[4 + j] * u1[j]; }
#pragma unroll
                for (int j = 0; j < 4; ++j) { bur += br[8 + j] * u2[j]; bui += bi[8 + j] * u2[j]; }
#pragma unroll
                for (int j = 0; j < 4; ++j) { bur += br[12 + j] * u3[j]; bui += bi[12 + j] * u3[j]; }
                const float nxr = ar * xr - ai * xi + bur, nxi = ar * xi + ai * xr + bui; xr = nxr; xi = nxi;
                if (PASS == 2) { xb[s * 132 + lane] = xr; xb[s * 132 + 64 + lane] = xi; }
            }
            if (PASS == 2) {
                WAVE_SYNC();
                const int s = lane >> 2, c4 = lane & 3;
                f32x4 y = {0.f, 0.f, 0.f, 0.f};
#pragma unroll 4
                for (int n4 = 0; n4 < 32; ++n4) {
                    const f32x4 xv = *(LAS f32x4*)(xb + s * 132 + n4 * 4);
#pragma unroll
                    for (int j = 0; j < 4; ++j) { const f32x4 cv = *(LAS f32x4*)(ct + (c4 * 4 + j) * 132 + n4 * 4); y[j] += dot4(xv, cv); }
                }
                const f32x4 uu = *(LAS f32x4*)(ubc + s * 16 + c4 * 4);
                const f32x4 dsk = *(const f32x4*)(p.in[30] + l * 512 + g * 16 + c4 * 4);
                y = y + dsk * uu;
                y.x = gelu_tanh(y.x); y.y = gelu_tanh(y.y); y.z = gelu_tanh(y.z); y.w = gelu_tanh(y.w);
                const size_t o = (size_t)(m0 + bt * 16 + s) * 512 + g * 16 + c4 * 4;
                *(f32x4*)(YS + o) = y;
                u32x2 w; w.x = cvt_pk_bf16(y.x, y.y); w.y = cvt_pk_bf16(y.z, y.w); *(u32x2*)(YSB + o) = w;
                WAVE_SYNC();
            }
        }
        if (PASS == 1) { XE[(u * 64 + lane) * 2] = xr; XE[(u * 64 + lane) * 2 + 1] = xi; }
    }
}
__device__ __forceinline__ void s5_combine(const Params& p, int l, int unit0, int ustride, int lane) {
    const float* tab = (const float*)(p.ws + WS_S5TAB + (size_t)l * SZ_S5TAB); const float* XE = (const float*)(p.ws + WS_XE); float* XIN = (float*)(p.ws + WS_XIN);
    for (int bg = unit0; bg < 64; bg += ustride) {
        const int g = bg & 31; float ar = tab[(g * 64 + lane) * 2], ai = tab[(g * 64 + lane) * 2 + 1];
#pragma unroll
        for (int i = 0; i < 8; ++i) { const float r2 = ar * ar - ai * ai, i2 = 2.f * ar * ai; ar = r2; ai = i2; }
        float xr = 0.f, xi = 0.f; asm volatile("" : "+v"(xr), "+v"(xi));
        for (int c = 0; c < 16; ++c) {
            const int u = bg * 16 + c;
            XIN[(u * 64 + lane) * 2] = xr; XIN[(u * 64 + lane) * 2 + 1] = xi;
            const float er = XE[(u * 64 + lane) * 2], ei = XE[(u * 64 + lane) * 2 + 1];
            const float nr = ar * xr - ai * xi + er, ni = ar * xi + ai * xr + ei; xr = nr; xi = ni;
        }
    }
}
template <int PASS>
__device__ __forceinline__ void rwkv_scan(const Params& p, int l, int wave, int lane, LAS unsigned char* lds) {
    if (wave >= 3) return;
    constexpr int NB = 2, NBT = 128 / NB;
    const int G = gridDim.x; unsigned char* ws = p.ws;
    LAS float* sb = (LAS float*)(lds + wave * 8192);
    LAS float* cb = sb + 1024 + lane;
    const float* ZR = (const float*)(ws + WS_ZR); const bf16_t* LR = (const bf16_t*)(ws + WS_LR);
    const float* SIN = (const float*)(ws + WS_SIN); bf16_t* YCAT = (bf16_t*)(ws + WS_YCAT);
    for (int u = wave * G + bidx(); u < 768; u += 3 * G) {
        const int c = u & 31, bh = u >> 5; const int b = bh / 12, h = bh - b * 12; const int ch = h * 64 + lane;
        const int m0 = b * SEQ + c * 128;
        cb[0] = p.in[7][l * RWC + ch]; cb[64] = p.in[7][l * RWC + 768 + ch]; cb[128] = p.in[7][l * RWC + 1536 + ch];
        cb[192] = p.in[13][l * 768 + ch]; cb[256] = p.in[14][l * 768 + ch]; cb[320] = p.in[8][l * 768 + ch]; cb[384] = p.in[10][l * 768 + ch];
        cb[448] = p.in[15][l * 768 + ch];
        if (PASS == 2) { cb[512] = p.in[16][l * 768 + ch]; cb[576] = p.in[17][l * 768 + ch]; }
        f32x2 s[32]; f32x2 pp[32];
        if (PASS == 1) {
#pragma unroll
            for (int j = 0; j < 32; ++j) { int ll = lane; asm volatile("" : "+v"(ll)); s[j] = (f32x2){0.f, 0.f}; pp[j] = (f32x2){(2 * j == ll) ? 1.f : 0.f, (2 * j + 1 == ll) ? 1.f : 0.f}; }
        } else {
#pragma unroll
            for (int j = 0; j < 32; ++j) { s[j] = (f32x2){SIN[((size_t)u * 64 + 2 * j) * 64 + lane], SIN[((size_t)u * 64 + 2 * j + 1) * 64 + lane]}; }
        }
        float pr = 0.f, pk = 0.f, pv = 0.f;
        if (c != 0) { const float* zp = ZR + (size_t)(m0 - 1) * RWC; pr = zp[ch]; pk = zp[768 + ch]; pv = zp[1536 + ch]; }
        float zr4[NB], zk4[NB], zv4[NB], de4[NB], aa4[NB], gg4[NB];
#pragma unroll
        for (int q = 0; q < NB; ++q) { const float* zb = ZR + (size_t)(m0 + q) * RWC; const bf16_t* lb = LR + (size_t)(m0 + q) * 2304; zr4[q] = zb[ch]; zk4[q] = (zb + 768)[ch]; zv4[q] = (zb + 1536)[ch]; de4[q] = BF2F(lb[ch]); aa4[q] = BF2F((lb + 768)[ch]); gg4[q] = (PASS == 2) ? BF2F((lb + 1536)[ch]) : 0.f; }
        for (int bt = 0; bt < NBT; ++bt) {
            float vv[NB];
            const float mu_r = cb[0], mu_k = cb[64], mu_v = cb[128], kkc = cb[192], kac = cb[256], w0c = cb[320], a0c = cb[384]; const float rkc = cb[448];
#pragma unroll
            for (int q = 0; q < NB; ++q) {
                const float r = zr4[q] + (pr - zr4[q]) * mu_r, k = zk4[q] + (pk - zk4[q]) * mu_k, v = zv4[q] + (pv - zv4[q]) * mu_v;
                pr = zr4[q]; pk = zk4[q]; pv = zv4[q];
                float kk = k * kkc; const float n2 = wave_sum(kk * kk); kk = kk * __builtin_amdgcn_rcpf(fmaxf(__builtin_amdgcn_sqrtf(n2), 1e-12f));
                const float a = sigmoidf_(a0c + aa4[q]); const float kmod = k * (1.0f + (a - 1.0f) * kac);
                LAS float* q5 = sb + q * 512 + lane;
                q5[0] = decay_of(w0c + de4[q]); q5[64] = -kk; q5[128] = kk * a; q5[192] = kmod; q5[256] = r; q5[320] = v;
                vv[q] = v;
                if (PASS == 2) { q5[384] = wave_sum(r * kmod * rkc) * v; q5[448] = gg4[q]; }
                if (PASS == 1) { const float bo = wave_sum(r * kmod * rkc) * v; ((bf16_t*)(ws + WS_BON))[(size_t)(m0 + bt * NB + q) * 768 + ch] = (bf16_t)(cvt_pk_bf16(bo, 0.f) & 0xffffu); }
            }
            if (bt + 1 < NBT) {
#pragma unroll
                for (int q = 0; q < NB; ++q) { const float* zb = ZR + (size_t)(m0 + (bt + 1) * NB + q) * RWC; const bf16_t* lb = LR + (size_t)(m0 + (bt + 1) * NB + q) * 2304; zr4[q] = zb[ch]; zk4[q] = (zb + 768)[ch]; zv4[q] = (zb + 1536)[ch]; de4[q] = BF2F(lb[ch]); aa4[q] = BF2F((lb + 768)[ch]); gg4[q] = (PASS == 2) ? BF2F((lb + 1536)[ch]) : 0.f; }
            }
            WAVE_SYNC();
            float yo[NB];
#define SB_ __builtin_amdgcn_sched_barrier(0)
#define LDV(dst, n, src) _Pragma("unroll") for (int j_ = 0; j_ < (n); ++j_) dst[j_] = (src)[j_]
            if (PASS == 1) {
                f32x4 H3[3][4];
#define RW1_VEC(k) (((k) < 4) ? 16 : (((k) >= 16) ? 64 : (((((k) - 4) % 3) == 0) ? 0 : (((((k) - 4) % 3) == 1) ? 32 : 48))))
#define RW1_QTR(k) (((k) < 4) ? (k) : (((k) >= 16) ? ((k) - 16) : (((k) - 4) / 3)))
#define RW1_PTR(g) ((const LAS f32x4*)(sb + ((g) / 20) * 512) + RW1_VEC((g) % 20) + RW1_QTR((g) % 20) * 4)
                LDV(H3[0], 4, RW1_PTR(0)); LDV(H3[1], 4, RW1_PTR(1));
#pragma unroll
                for (int q = 0; q < NB; ++q) {
                    const float vq = sb[q * 512 + 320 + lane];
                    f32x2 as0, ap0, sas2, sap2; const f32x2 v2 = {vq, vq};
#pragma unroll
                    for (int k = 0; k < 20; ++k) {
                        const int g = q * 20 + k; const int c8 = RW1_QTR(k) * 8; const int t = (k < 4) ? -1 : ((k >= 16) ? 3 : ((k - 4) % 3));
                        if (g + 2 < NB * 20) { LDV(H3[(g + 2) % 3], 4, RW1_PTR(g + 2)); }
                        SB_;
#pragma unroll
                        for (int j = 0; j < 4; ++j) {
                            const f32x4 o4 = H3[g % 3][j]; const f32x2 lo = {o4.x, o4.y}, hi = {o4.z, o4.w};
                            if (t < 0) { if (k == 0 && j == 0) { as0 = s[c8] * lo; ap0 = pp[c8] * lo; } else { as0 += s[c8 + 2 * j] * lo; ap0 += pp[c8 + 2 * j] * lo; } as0 += s[c8 + 2 * j + 1] * hi; ap0 += pp[c8 + 2 * j + 1] * hi; }
                            else if (t == 0) { s[c8 + 2 * j] *= lo; s[c8 + 2 * j + 1] *= hi; pp[c8 + 2 * j] *= lo; pp[c8 + 2 * j + 1] *= hi; }
                            else if (t == 1) { s[c8 + 2 * j] += sas2 * lo; s[c8 + 2 * j + 1] += sas2 * hi; pp[c8 + 2 * j] += sap2 * lo; pp[c8 + 2 * j + 1] += sap2 * hi; }
                            else if (t == 2) { s[c8 + 2 * j] += v2 * lo; s[c8 + 2 * j + 1] += v2 * hi; }
                            else { if (k == 16 && j == 0) { as0 = s[c8] * lo; ap0 = pp[c8] * lo; } else { as0 += s[c8 + 2 * j] * lo; ap0 += pp[c8 + 2 * j] * lo; } as0 += s[c8 + 2 * j + 1] * hi; ap0 += pp[c8 + 2 * j + 1] * hi; }
                        }
                        if (k == 19) { const size_t o = (size_t)(m0 + bt * NB + q) * 768 + ch; ((float*)(ws + WS_YL))[o] = as0.x + as0.y; ((float*)(ws + WS_QQ))[o] = ap0.x + ap0.y; }
                        if (k == 3) { const float sas = as0.x + as0.y, sap = ap0.x + ap0.y; sas2 = (f32x2){sas, sas}; sap2 = (f32x2){sap, sap}; }
                        SB_;
                    }
                }
#undef RW1_PTR
#undef RW1_QTR
#undef RW1_VEC
            } else {
                f32x4 H3[2][8];
#define RW2_PTR(g) ((const LAS f32x4*)(sb + ((g) / 10) * 512) + ((((g) % 10) / 2 == 0) ? 16 : ((((g) % 10) / 2 == 1) ? 0 : ((((g) % 10) / 2 == 2) ? 32 : ((((g) % 10) / 2 == 3) ? 48 : 64)))) + ((g) % 2) * 8)
                LDV(H3[0], 8, RW2_PTR(0));
#pragma unroll
                for (int q = 0; q < NB; ++q) {
                    f32x2 as0, as1, ay0, ay1, sas2; const f32x2 v2 = {vv[q], vv[q]};
#pragma unroll
                    for (int k = 0; k < 10; ++k) {
                        const int g = q * 10 + k; const int h16 = (k & 1) * 16;
                        if (g + 1 < NB * 10) { LDV(H3[(g + 1) % 2], 8, RW2_PTR(g + 1)); }
                        SB_;
#pragma unroll
                        for (int j = 0; j < 8; ++j) {
                            const f32x4 o4 = H3[g % 2][j]; const f32x2 lo = {o4.x, o4.y}, hi = {o4.z, o4.w};
                            if (k < 2) { if (k == 0 && j == 0) { as0 = s[0] * lo; as1 = s[1] * hi; } else { as0 += s[h16 + 2 * j] * lo; as1 += s[h16 + 2 * j + 1] * hi; } }
                            else if (k < 4) { s[h16 + 2 * j] *= lo; s[h16 + 2 * j + 1] *= hi; }
                            else if (k < 6) { s[h16 + 2 * j] += sas2 * lo; s[h16 + 2 * j + 1] += sas2 * hi; }
                            else if (k < 8) { s[h16 + 2 * j] += v2 * lo; s[h16 + 2 * j + 1] += v2 * hi; }
                            else { if (k == 8 && j == 0) { ay0 = s[0] * lo; ay1 = s[1] * hi; } else { ay0 += s[h16 + 2 * j] * lo; ay1 += s[h16 + 2 * j + 1] * hi; } }
                        }
                        if (k == 1) { const float sas = (as0.x + as0.y) + (as1.x + as1.y); sas2 = (f32x2){sas, sas}; }
                        SB_;
                    }
                    yo[q] = (ay0.x + ay0.y) + (ay1.x + ay1.y);
                }
#undef RW2_PTR
            }
#undef SB_
#undef LDV
            if (PASS == 2) {
#pragma unroll
                for (int q = 0; q < NB; ++q) {
                    const float mean = wave_sum(yo[q]) * (1.0f / 64.0f); const float d = yo[q] - mean; const float var = wave_sum(d * d) * (1.0f / 64.0f);
                    const float gnw = cb[512], gnb = cb[576]; const float yn = d * rsqrtf(var + 64e-5f) * gnw + gnb; const float o = (yn + sb[q * 512 + 384 + lane]) * sb[q * 512 + 448 + lane];
                    YCAT[(size_t)(m0 + bt * NB + q) * DM + ch] = (bf16_t)(cvt_pk_bf16(o, 0.f) & 0xffffu);
                }
            }
            WAVE_SYNC();
        }
        if (PASS == 1) {
            int ll = lane; asm volatile("" : "+v"(ll));
            unsigned char* wsl = p.ws; asm volatile("" : "+s"(wsl)); int ul = u; asm volatile("" : "+s"(ul));
            float* sp = (float*)(wsl + WS_SEND) + (size_t)ul * 8192 + ll;
#pragma unroll
            for (int j = 0; j < 32; ++j) {
                sp[(2 * j) * 64] = s[j].x; sp[(2 * j + 1) * 64] = s[j].y;
                sp[(64 + 2 * j) * 64] = pp[j].x; sp[(64 + 2 * j + 1) * 64] = pp[j].y;
            }
        }
    }
}
__device__ __forceinline__ void rwkv_out(const Params& p, int l, int wave, int lane, LAS unsigned char* lds) {
    unsigned char* ws = p.ws; const int G = gridDim.x;
    const float* SIN = (const float*)(ws + WS_SIN); const float* YL = (const float*)(ws + WS_YL); const float* QQ = (const float*)(ws + WS_QQ);
    const bf16_t* BON = (const bf16_t*)(ws + WS_BON); const bf16_t* LR = (const bf16_t*)(ws + WS_LR); bf16_t* YCAT = (bf16_t*)(ws + WS_YCAT);
    LAS float* qb = (LAS float*)(lds + wave * 1024);
    for (int u2 = wave * G + bidx(); u2 < 3072; u2 += 8 * G) {
        const int u = u2 >> 2, qt = u2 & 3; const int c = u & 31, bh = u >> 5; const int b = bh / 12, h = bh - b * 12; const int ch = h * 64 + lane;
        const int m0 = b * SEQ + c * 128 + qt * 32;
        const float gnw = p.in[16][l * 768 + ch], gnb = p.in[17][l * 768 + ch];
        f32x2 s[32];
        { const float* sb_ = SIN + (size_t)u * 4096 + lane;
#pragma unroll
          for (int j = 0; j < 32; ++j) s[j] = (f32x2){sb_[(2 * j) * 64], sb_[(2 * j + 1) * 64]}; }
        float q4[4], y4[4], b4[4], g4[4];
#pragma unroll
        for (int q = 0; q < 4; ++q) { const size_t o = (size_t)(m0 + q) * 768; q4[q] = (QQ + o)[ch]; y4[q] = (YL + o)[ch]; b4[q] = BF2F((BON + o)[ch]); g4[q] = BF2F((LR + (size_t)(m0 + q) * 2304 + 1536)[ch]); }
        for (int bt = 0; bt < 8; ++bt) {
            float yc[4], bc[4], gc[4];
#pragma unroll
            for (int q = 0; q < 4; ++q) { qb[q * 64 + lane] = q4[q]; yc[q] = y4[q]; bc[q] = b4[q]; gc[q] = g4[q]; }
            if (bt + 1 < 8) {
#pragma unroll
                for (int q = 0; q < 4; ++q) { const size_t o = (size_t)(m0 + (bt + 1) * 4 + q) * 768; q4[q] = (QQ + o)[ch]; y4[q] = (YL + o)[ch]; b4[q] = BF2F((BON + o)[ch]); g4[q] = BF2F((LR + (size_t)(m0 + (bt + 1) * 4 + q) * 2304 + 1536)[ch]); }
            }
            WAVE_SYNC();
#pragma unroll
            for (int q = 0; q < 4; ++q) {
                const LAS f32x4* Q4 = (const LAS f32x4*)(qb + q * 64);
                f32x2 a0 = {0.f, 0.f}, a1 = {0.f, 0.f};
#pragma unroll
                for (int j = 0; j < 16; ++j) { const f32x4 v = Q4[j]; a0 += s[2 * j] * (f32x2){v.x, v.y}; a1 += s[2 * j + 1] * (f32x2){v.z, v.w}; }
                const float yo = yc[q] + (a0.x + a0.y) + (a1.x + a1.y);
                const float mean = wave_sum(yo) * (1.0f / 64.0f); const float d = yo - mean; const float var = wave_sum(d * d) * (1.0f / 64.0f);
                const float o = (d * rsqrtf(var + 64e-5f) * gnw + gnb + bc[q]) * gc[q];
                YCAT[(size_t)(m0 + bt * 4 + q) * DM + ch] = (bf16_t)(cvt_pk_bf16(o, 0.f) & 0xffffu);
            }
            WAVE_SYNC();
        }
    }
}
__device__ __forceinline__ void rwkv_combine(const Params& p, int bh, int wave, int lane, LAS unsigned char* lds) {
    LAS float* xs = (LAS float*)lds;
    LAS float* pw = (LAS float*)(lds + 16384 + wave * 2048);
    const float* SEND = (const float*)(p.ws + WS_SEND) + (size_t)bh * 32 * 8192 + (size_t)(wave * 8) * 64 + lane; float* SIN = (float*)(p.ws + WS_SIN) + (size_t)bh * 32 * 4096 + (size_t)(wave * 8) * 64 + lane;
    f32x2 s[32];
#pragma unroll
    for (int j = 0; j < 32; ++j) s[j] = (f32x2){0.f, 0.f};
    float own[8], pj[4][8], sl[4][8];
#pragma unroll
    for (int jj = 0; jj < 8; ++jj) own[jj] = 0.f;
#pragma unroll
    for (int d = 0; d < 4; ++d)
#pragma unroll
        for (int jj = 0; jj < 8; ++jj) { pj[d][jj] = SEND[(size_t)d * 8192 + (64 + jj) * 64]; sl[d][jj] = SEND[(size_t)d * 8192 + jj * 64]; }
    for (int c4 = 0; c4 < 8; ++c4) {
#pragma unroll
        for (int cc = 0; cc < 4; ++cc) {
            const int c = c4 * 4 + cc;
            float slc[8];
#pragma unroll
            for (int jj = 0; jj < 8; ++jj) { SIN[(size_t)c * 4096 + jj * 64] = own[jj]; pw[jj * 64 + lane] = pj[cc][jj]; slc[jj] = sl[cc][jj]; }
            if (c + 4 < 32) {
#pragma unroll
                for (int jj = 0; jj < 8; ++jj) { pj[cc][jj] = SEND[(size_t)(c + 4) * 8192 + (64 + jj) * 64]; sl[cc][jj] = SEND[(size_t)(c + 4) * 8192 + jj * 64]; }
            }
            WAVE_SYNC();
#pragma unroll
            for (int jj = 0; jj < 8; ++jj) {
                f32x2 a0 = {0.f, 0.f}, a1 = {0.f, 0.f};
#pragma unroll
                for (int i4 = 0; i4 < 16; ++i4) { const f32x4 pv = *(const LAS f32x4*)(pw + jj * 64 + i4 * 4); a0 += s[2 * i4] * (f32x2){pv.x, pv.y}; a1 += s[2 * i4 + 1] * (f32x2){pv.z, pv.w}; }
                own[jj] = slc[jj] + (a0.x + a0.y) + (a1.x + a1.y);
                xs[(wave * 8 + jj) * 64 + lane] = own[jj];
            }
            __syncthreads();
#pragma unroll
            for (int j = 0; j < 32; ++j) s[j] = (f32x2){xs[(2 * j) * 64 + lane], xs[(2 * j + 1) * 64 + lane]};
            __syncthreads();
        }
    }
}

constexpr int KP = 136, VP = 72;
constexpr int ATT_BUF = 64 * KP * 2 + 128 * VP * 2;
__device__ __forceinline__ void attn_phase(const Params& p, int l, int wave, int lane, LAS unsigned char* lds, int early) {
    const int tid = tidx(); unsigned char* ws = p.ws;
    const bf16_t* DAQK = (const bf16_t*)(ws + WS_DAQK); const bf16_t* VT = (const bf16_t*)(ws + WS_VT); bf16_t* YCAT = (bf16_t*)(ws + WS_YCAT);
    const float lam_init = 0.8f - 0.6f * expf(-0.3f * (float)l);
    const float d1 = wave_sum(p.in[18][l * 64 + lane] * p.in[19][l * 64 + lane]), d2 = wave_sum(p.in[20][l * 64 + lane] * p.in[21][l * 64 + lane]);
    const float lam = expf(d1) - expf(d2) + lam_init;
    const int sub = wave >> 2, rq = (wave & 3) * 32, qi = lane & 15, g4 = lane >> 4;
    const int x16 = (lane ^ 16) << 2, x32 = (lane ^ 32) << 2;
#define SHX(v, a) __builtin_bit_cast(float, __builtin_amdgcn_ds_bpermute((a), __builtin_bit_cast(int, (v))))
    unsigned* aq = (unsigned*)ws + 256 + l; unsigned* dn = (unsigned*)ws + 264 + l;
    volatile LAS int* ubox = (volatile LAS int*)(lds + 143360);
    for (;;) {
        __syncthreads();
        if (tid == 0) { int un = 384;
            if (!(early && __hip_atomic_load(dn, __ATOMIC_RELAXED, __HIP_MEMORY_SCOPE_AGENT) >= 24u)) un = (int)__hip_atomic_fetch_add(aq, 1u, __ATOMIC_RELAXED, __HIP_MEMORY_SCOPE_AGENT);
            *ubox = un; }
        __syncthreads();
        const int u = *ubox;
        if (u >= 384) break;
        const int qb = 31 - u / 12, rem = u % 12, b = rem / 6, h = rem % 6;
        const int q0 = qb * 128, kl = 2 * qb + 1;
        bf16x8 qf[2][2];
#pragma unroll
        for (int rt = 0; rt < 2; ++rt) { const bf16_t* qp = DAQK + (size_t)(b * SEQ + q0 + rq + 16 * rt + qi) * 1536 + h * 128 + sub * 64 + g4 * 8; qf[rt][0] = *(const bf16x8*)qp; qf[rt][1] = *(const bf16x8*)(qp + 32); }
        f32x4 o[2][8];
#pragma unroll
        for (int rt = 0; rt < 2; ++rt)
#pragma unroll
            for (int e = 0; e < 8; ++e) o[rt][e] = (f32x4){0.f, 0.f, 0.f, 0.f};
        float mrun[2] = {-1e30f, -1e30f}, lrun[2] = {0.f, 0.f};
        const int kr0 = tid >> 4, kc0 = tid & 15;
        const int vr0 = tid >> 3, vc0 = tid & 7;
        const bf16_t* kbase = DAQK + (size_t)(b * SEQ) * 1536 + 768 + h * 128 + kc0 * 8;
        const bf16_t* vbase = VT + (size_t)(b * 768 + h * 128) * SEQ + vc0 * 8;
        u32x4 kreg[2], vreg[2];
#define ATT_LOADR(KR, VR, kb) do { KR[0] = *(const u32x4*)(kbase + (size_t)((kb) * 64 + kr0) * 1536); KR[1] = *(const u32x4*)(kbase + (size_t)((kb) * 64 + kr0 + 32) * 1536); \
        VR[0] = *(const u32x4*)(vbase + (size_t)vr0 * SEQ + (kb) * 64); VR[1] = *(const u32x4*)(vbase + (size_t)(vr0 + 64) * SEQ + (kb) * 64); } while (0)
#define ATT_STORER(KR, VR, buf) do { LAS unsigned char* kb_ = lds + (buf) * ATT_BUF; LAS unsigned char* vb_ = kb_ + 64 * KP * 2; \
        *(LAS u32x4*)(kb_ + (kr0 * KP + kc0 * 8) * 2) = KR[0]; *(LAS u32x4*)(kb_ + ((kr0 + 32) * KP + kc0 * 8) * 2) = KR[1]; \
        *(LAS u32x4*)(vb_ + (vr0 * VP + vc0 * 8) * 2) = VR[0]; *(LAS u32x4*)(vb_ + ((vr0 + 64) * VP + vc0 * 8) * 2) = VR[1]; } while (0)
#define ATT_COMPUTE(kb) do { \
            const LAS unsigned char* kt = lds + ((kb) & 1) * ATT_BUF; const LAS unsigned char* vt = kt + 64 * KP * 2; \
            f32x4 st[2][4]; \
            __builtin_amdgcn_s_setprio(1); \
            _Pragma("unroll") for (int mt = 0; mt < 4; ++mt) { \
                st[0][mt] = (f32x4){0.f, 0.f, 0.f, 0.f}; st[1][mt] = (f32x4){0.f, 0.f, 0.f, 0.f}; \
                _Pragma("unroll") for (int ks = 0; ks < 2; ++ks) { \
                    const bf16x8 ka = *(const LAS bf16x8*)(kt + ((16 * mt + qi) * KP + sub * 64 + ks * 32 + g4 * 8) * 2); \
                    st[0][mt] = __builtin_amdgcn_mfma_f32_16x16x32_bf16(ka, qf[0][ks], st[0][mt], 0, 0, 0); \
                    st[1][mt] = __builtin_amdgcn_mfma_f32_16x16x32_bf16(ka, qf[1][ks], st[1][mt], 0, 0, 0); \
                } \
            } \
            __builtin_amdgcn_s_setprio(0); \
            bf16x8 pb[2][2]; \
            _Pragma("unroll") for (int rt = 0; rt < 2; ++rt) { \
                const int qrel = q0 + rq + 16 * rt - (kb) * 64;            \
                if (qrel < 63) { \
                    _Pragma("unroll") for (int mt = 0; mt < 4; ++mt) \
                        _Pragma("unroll") for (int i = 0; i < 4; ++i) if (16 * mt + 4 * g4 + i > qrel + qi) st[rt][mt][i] = -1e30f; \
                } \
                float mx = st[rt][0][0]; \
                _Pragma("unroll") for (int mt = 0; mt < 4; ++mt) \
                    _Pragma("unroll") for (int i = 0; i < 4; ++i) mx = fmaxf(mx, st[rt][mt][i]); \
                mx = fmaxf(mx, SHX(mx, x16)); mx = fmaxf(mx, SHX(mx, x32)); \
                const float mnew = fmaxf(mrun[rt], mx); const float alpha = __builtin_amdgcn_exp2f(mrun[rt] - mnew); mrun[rt] = mnew; \
                float ps = 0.f; \
                _Pragma("unroll") for (int mt = 0; mt < 4; ++mt) \
                    _Pragma("unroll") for (int i = 0; i < 4; ++i) { const float e = __builtin_amdgcn_exp2f(st[rt][mt][i] - mnew); st[rt][mt][i] = e; ps += e; } \
                lrun[rt] = lrun[rt] * alpha + ps; \
                if (__builtin_amdgcn_ballot_w64(alpha != 1.0f) != 0ull) { _Pragma("unroll") for (int e = 0; e < 8; ++e) o[rt][e] = o[rt][e] * alpha; } \
                _Pragma("unroll") for (int jp = 0; jp < 2; ++jp) { \
                    u32x4 pw4; pw4.x = cvt_pk_bf16(st[rt][2 * jp][0], st[rt][2 * jp][1]); pw4.y = cvt_pk_bf16(st[rt][2 * jp][2], st[rt][2 * jp][3]); \
                    pw4.z = cvt_pk_bf16(st[rt][2 * jp + 1][0], st[rt][2 * jp + 1][1]); pw4.w = cvt_pk_bf16(st[rt][2 * jp + 1][2], st[rt][2 * jp + 1][3]); \
                    pb[rt][jp] = __builtin_bit_cast(bf16x8, pw4); } \
            } \
            __builtin_amdgcn_s_setprio(1); \
            _Pragma("unroll") for (int jp = 0; jp < 2; ++jp) \
                _Pragma("unroll") for (int e = 0; e < 8; ++e) { \
                    const LAS unsigned char* vp = vt + ((16 * e + qi) * VP + 32 * jp + 4 * g4) * 2; \
                    const u32x2 lo = *(const LAS u32x2*)vp, hi = *(const LAS u32x2*)(vp + 32); \
                    u32x4 va4; va4.x = lo.x; va4.y = lo.y; va4.z = hi.x; va4.w = hi.y; const bf16x8 va = __builtin_bit_cast(bf16x8, va4); \
                    o[0][e] = __builtin_amdgcn_mfma_f32_16x16x32_bf16(va, pb[0][jp], o[0][e], 0, 0, 0); \
                    o[1][e] = __builtin_amdgcn_mfma_f32_16x16x32_bf16(va, pb[1][jp], o[1][e], 0, 0, 0); \
                } \
            __builtin_amdgcn_s_setprio(0); \
        } while (0)
        __syncthreads();
        ATT_LOADR(kreg, vreg, 0); ATT_STORER(kreg, vreg, 0);
        __syncthreads();
        for (int kb = 0; kb <= kl; ++kb) {
            if (kb < kl) ATT_LOADR(kreg, vreg, kb + 1);
            ATT_COMPUTE(kb);
            if (kb < kl) ATT_STORER(kreg, vreg, (kb + 1) & 1);
            __syncthreads();
        }
#undef ATT_LOADR
#undef ATT_STORER
#undef ATT_COMPUTE
        float inv[2];
#pragma unroll
        for (int rt = 0; rt < 2; ++rt) { float lt = lrun[rt]; lt += SHX(lt, x16); lt += SHX(lt, x32); inv[rt] = 1.0f / lt; }
        if (sub == 1) {
#pragma unroll
            for (int rt = 0; rt < 2; ++rt) { LAS float* ox = (LAS float*)lds + ((wave & 3) * 2 + rt) * 2048;
#pragma unroll
                for (int e = 0; e < 8; ++e)
#pragma unroll
                    for (int i = 0; i < 4; ++i) ox[(16 * e + 4 * g4 + i) * 16 + qi] = o[rt][e][i] * inv[rt]; }
        }
        __syncthreads();
        if (sub == 0) {
#pragma unroll
            for (int rt = 0; rt < 2; ++rt) {
                const LAS float* ox = (const LAS float*)lds + ((wave & 3) * 2 + rt) * 2048;
                float ssq = 0.f;
#pragma unroll
                for (int e = 0; e < 8; ++e)
#pragma unroll
                    for (int i = 0; i < 4; ++i) { const float v = o[rt][e][i] * inv[rt] - lam * ox[(16 * e + 4 * g4 + i) * 16 + qi]; o[rt][e][i] = v; ssq += v * v; }
                ssq += SHX(ssq, x16); ssq += SHX(ssq, x32);
                const float rn = rsqrtf(ssq * (1.0f / 128.0f) + 1e-5f) * (1.0f - lam_init);
                bf16_t* yp = YCAT + (size_t)(b * SEQ + q0 + rq + 16 * rt + qi) * DM + 768 + h * 128;
#pragma unroll
                for (int e = 0; e < 8; ++e) {
                    const f32x4 sw = *(const f32x4*)(p.in[22] + l * 128 + 16 * e + 4 * g4);
                    u32x2 w; w.x = cvt_pk_bf16(o[rt][e][0] * rn * sw.x, o[rt][e][1] * rn * sw.y); w.y = cvt_pk_bf16(o[rt][e][2] * rn * sw.z, o[rt][e][3] * rn * sw.w);
                    *(u32x2*)(yp + 16 * e + 4 * g4) = w;
                }
            }
        }
    }
}
template <class Epi>
__device__ __forceinline__ void run_gemm(LAS unsigned char* lds, const bf16_t* A, const bf16_t* Bt, int N, int K, const Epi& E) {
    pg8::Gemm g; g.A = A; g.Bt = Bt; g.M = MT; g.N = N; g.K = K;
    pg8::StaticOrder S; S.init(MT, N, gridDim.x, bidx());
    pg8::gemm_phase<Epi, pg8::StaticOrder, true, true>(lds, g, S, E);
}

#ifndef PHASE_MASK
#define PHASE_MASK 0xFFFFu
#endif
constexpr unsigned PHM = PHASE_MASK;
#ifndef DUP_MASK
#define DUP_MASK 0
#endif
constexpr unsigned DUPM = DUP_MASK;
#define PON(k) ((PHM >> (k)) & 1u)
__global__ void __launch_bounds__(512, 2) mk_fwd(Params p) {
    extern __shared__ __attribute__((aligned(16))) unsigned char smem[];
    LAS unsigned char* lds = (LAS unsigned char*)smem;
    cg::grid_group grid = cg::this_grid();
    volatile LAS unsigned* xst = (volatile LAS unsigned*)(lds + 143368);
    if (threadIdx.x == 0) { xst[0] = 0u; xst[1] = 0u;
        __hip_atomic_fetch_add((unsigned*)p.ws + 1536 + ((unsigned)__builtin_amdgcn_s_getreg((3 << 11) | 20) & 0xFu), 1u, __ATOMIC_RELAXED, __HIP_MEMORY_SCOPE_AGENT); }
    __syncthreads();
    unsigned char* ws = p.ws;
    bf16_t* XB = (bf16_t*)(ws + WS_XB); float* RS = (float*)(ws + WS_RS); bf16_t* YCAT = (bf16_t*)(ws + WS_YCAT);
    bf16_t* ACT = (bf16_t*)(ws + WS_ACT); bf16_t* H = (bf16_t*)(ws + WS_H);
    for (int ph = p.ph_lo; ph < p.ph_hi; ++ph) {
        const int s_ = (ph == 0) ? -1 : (ph - 1) % NPL;
        int nrep = 1;
        if (DUPM) { const int kind = (ph == 0) ? 0 : ((s_ == 0 || s_ == 13) ? 1 : ((s_ == 1 || s_ == 14 || s_ == 11 || s_ == 5) ? 2 : ((s_ == 2 || s_ == 12 || s_ == 15) ? 3 : ((s_ == 3) ? 4 : (s_ - 4 + 5)))));
            if ((DUPM >> kind) & 1u) nrep = 2; }
        for (int rep = 0; rep < nrep; ++rep) {
        if (rep) grid.sync();
        const int tid = tidx(), lane = tid & 63, wave = __builtin_amdgcn_readfirstlane(tid >> 6);
        if (ph == 0) { if (PON(0)) prologue(p, lds, wave, lane); }
        else {
            const int l = (ph - 1) / NPL, s = (ph - 1) % NPL;
            if ((s == 0 || s == 13) && PON(1)) {
                EpiGU E; E.ACT = ACT; E.rs = RS;
                run_gemm(lds, XB, (const bf16_t*)(ws + WS_WGU + (size_t)(l * 2 + (s == 13)) * SZ_WGU), 2 * FF, DM, E);
            } else if ((s == 1 || s == 14 || s == 11 || s == 5) && PON(2)) {
                EpiBF E; E.C = (s == 5) ? (bf16_t*)(ws + WS_LR) : H; E.ldc = (s == 5) ? 2304 : DM;
                const bf16_t* Ag = (s == 11) ? YCAT : ((s == 5) ? (const bf16_t*)(ws + WS_LA) : ACT);
                const bf16_t* Bg = (s == 11) ? (const bf16_t*)(ws + WS_WOUT + (size_t)l * SZ_WOUT) : ((s == 5) ? (const bf16_t*)(ws + WS_WLORA + (size_t)l * SZ_WLORA) : (const bf16_t*)(ws + WS_WD + (size_t)(l * 2 + (s == 14)) * SZ_WD));
                run_gemm(lds, Ag, Bg, (s == 5) ? 2304 : DM, (s == 11) ? DM : ((s == 5) ? 256 : FF), E);
                if (s != 5 && gridDim.x == 256) {
                    pg8::StaticOrder S; S.init(MT, DM, 256, bidx()); Unit un; S.next(0, un);
                    const int wh = (s == 1) ? 0 : ((s == 11) ? 1 : 2);
                    unsigned* cnt = (unsigned*)ws + (l * 3 + wh) * 32 + un.pm;
                    __syncthreads();
                    if (tidx() == 0) { __threadfence(); __hip_atomic_fetch_add(cnt, 1u, __ATOMIC_RELAXED, __HIP_MEMORY_SCOPE_AGENT);
                        while (__hip_atomic_load(cnt, __ATOMIC_RELAXED, __HIP_MEMORY_SCOPE_AGENT) < 8u) __builtin_amdgcn_s_sleep(2);
                        __threadfence(); }
                    __syncthreads();
                    const int tid2 = tidx(), lane2 = tid2 & 63, wave2 = __builtin_amdgcn_readfirstlane(tid2 >> 6);
                    const float* g = p.in[s == 1 ? 4 : (s == 11 ? 34 : 38)] + l * DM;
                    row_phase(H, nullptr, (ph == NPH - 2) ? p.out : nullptr, XB, RS, g, s == 11 ? 1.0f : 0.5f, wave2, lane2, un.pm * 256 + un.pn * 32, 32);
                }
            } else if ((s == 2 || s == 12 || s == 15) && PON(3) && gridDim.x != 256) {
                const float* g = p.in[s == 2 ? 4 : (s == 12 ? 34 : 38)] + l * DM;
                row_phase(H, nullptr, (ph == NPH - 1) ? p.out : nullptr, XB, RS, g, s == 12 ? 1.0f : 0.5f, wave, lane);
            } else if (s == 3 && PON(4)) {
                EpiIN E; E.ZR = (float*)(ws + WS_ZR); E.DAQK = (bf16_t*)(ws + WS_DAQK); E.VT = (bf16_t*)(ws + WS_VT); E.ZS = (float*)(ws + WS_ZS); E.rs = RS;
                run_gemm(lds, XB, (const bf16_t*)(ws + WS_WIN + (size_t)l * SZ_WIN), INC, DM, E);
            } else if (s == 4 && PON(5)) {
                la_prep(p, l);
                s5_scan<1>(p, l, wave - 4, 4, bidx(), gridDim.x, lane, lds);
            } else if (s == 6 && PON(7)) {
                rwkv_scan<1>(p, l, wave, lane, lds);
                s5_scan<2>(p, l, (wave == 3) ? 0 : ((wave == 7) ? 1 : -1), 2, bidx(), gridDim.x, lane, lds + 24576);
            } else if ((s == 7 || s == 9) && PON(8)) {
                const int tid_ = tidx(), lane = tid_ & 63, wave = __builtin_amdgcn_readfirstlane(tid_ >> 6);
                const int G = gridDim.x; bool do_attn = true;
                if (s == 7) {
                    if (G >= 48) {
                        if (bidx() < 24) { rwkv_combine(p, bidx(), wave, lane, lds);
                            __syncthreads(); if (tidx() == 0) __hip_atomic_fetch_add((unsigned*)ws + 264 + l, 1u, __ATOMIC_RELAXED, __HIP_MEMORY_SCOPE_AGENT);
                            do_attn = false; }
                        else if (l == 0) { for (int gt = 2536 + bidx() - 24; gt < 2536 + 1376; gt += G - 24) weight_tile(p, gt, lds); }
                    } else {
                        for (int bh = bidx(); bh < 24; bh += G) rwkv_combine(p, bh, wave, lane, lds);
                        if (l == 0) { __syncthreads(); for (int gt = 2536 + bidx(); gt < 2536 + 1376; gt += G) weight_tile(p, gt, lds); }
                        do_attn = false;
                    }
                } else {
                    EpiGLU E; E.YCAT = YCAT; E.YS = (const float*)(ws + WS_YS); E.bglu = p.in[32] + l * 512;
                    run_gemm(lds, (const bf16_t*)(ws + WS_YSB), (const bf16_t*)(ws + WS_WGLU + (size_t)l * SZ_WGLU), 512, 512, E);
                }
                if (do_attn && PON(11)) attn_phase(p, l, wave, lane, lds, s == 7);
            } else if (s == 8 && PON(9)) {
                rwkv_out(p, l, wave, lane, lds);
            }
        }
        }
        { const int sx = (ph > 0) ? (ph - 1) % NPL : -1; const bool skip = (sx == 10) || (gridDim.x == 256 && (sx == 2 || sx == 12 || sx == 15));
          if (ph + 1 < p.ph_hi && !skip) {
              if (ph == p.ph_lo) grid.sync();
              else {
                  asm volatile("s_waitcnt vmcnt(0)" ::: "memory");
                  __syncthreads();
                  if (threadIdx.x == 0) {
                      unsigned* wsw = (unsigned*)p.ws; unsigned* base = wsw + 16384 + ph * 4096;
                      const unsigned xcc = (unsigned)__builtin_amdgcn_s_getreg((3 << 11) | 20) & 0xFu;
                      unsigned nloc = xst[0], nx = xst[1];
                      if (nloc == 0u) {
                          nx = 0u;
#pragma unroll
                          for (unsigned j = 0; j < 16; ++j) { const unsigned cj = __hip_atomic_load(wsw + 1536 + j, __ATOMIC_RELAXED, __HIP_MEMORY_SCOPE_AGENT); nx += (cj > 0u) ? 1u : 0u; nloc = (j == xcc) ? cj : nloc; }
                          xst[0] = nloc; xst[1] = nx;
                      }
                      const unsigned old = __hip_atomic_fetch_add(base + xcc * 64, 1u, __ATOMIC_RELAXED, __HIP_MEMORY_SCOPE_AGENT);
                      if (old + 1u == nloc) {
                          __builtin_amdgcn_fence(__ATOMIC_RELEASE, "agent");
                          asm volatile("s_waitcnt vmcnt(0)" ::: "memory");
                          const unsigned ot = __hip_atomic_fetch_add(base + 2048, 1u, __ATOMIC_RELAXED, __HIP_MEMORY_SCOPE_AGENT);
                          if (ot + 1u != nx) while (__hip_atomic_load(base + 2048, __ATOMIC_RELAXED, __HIP_MEMORY_SCOPE_AGENT) < nx) __builtin_amdgcn_s_sleep(1);
                          __builtin_amdgcn_fence(__ATOMIC_ACQUIRE, "agent");
                          __hip_atomic_fetch_add(base + 1024 + xcc * 64, 1u, __ATOMIC_RELAXED, __HIP_MEMORY_SCOPE_AGENT);
                          asm volatile("s_waitcnt vmcnt(0)" ::: "memory");
                      } else {
                          while (__hip_atomic_load(base + 1024 + xcc * 64, __ATOMIC_RELAXED, __HIP_MEMORY_SCOPE_AGENT) == 0u) __builtin_amdgcn_s_sleep(1);
                          __builtin_amdgcn_fence(__ATOMIC_ACQUIRE, "agent");
                          asm volatile("s_waitcnt vmcnt(0)" ::: "memory");
                      }
                  }
                  __syncthreads();
              }
          } }
    }
}

extern "C" void kernel_launch(void* const* d_in, const int* in_sizes, int n_in, void* d_out, int out_size, void* d_ws, size_t ws_size, hipStream_t stream) {
    static int grid = 0;
    if (grid == 0) {
        if (n_in != 39 || out_size != MT * DM || ws_size < WS_END) { fprintf(stderr, "kernel_launch: unexpected sizes: n_in %d out %d ws %zu (need %zu)\n", n_in, out_size, ws_size, (size_t)WS_END); grid = -1; return; }
        int dev = 0, cus = 0, per_cu = 0;
        hipGetDevice(&dev); hipDeviceGetAttribute(&cus, hipDeviceAttributeMultiprocessorCount, dev);
        if (hipFuncSetAttribute((const void*)mk_fwd, hipFuncAttributeMaxDynamicSharedMemorySize, LDS_BYTES) != hipSuccess) { fprintf(stderr, "kernel_launch: hipFuncSetAttribute failed\n"); grid = -1; return; }
        if (hipOccupancyMaxActiveBlocksPerMultiprocessor(&per_cu, (const void*)mk_fwd, 512, LDS_BYTES) != hipSuccess || per_cu < 1) { fprintf(stderr, "kernel_launch: occupancy query gives %d\n", per_cu); per_cu = 1; }
        (void)hipGetLastError();
        grid = cus * 1;
        fprintf(stderr, "kernel_launch: cus %d per_cu %d grid %d\n", cus, per_cu, grid);
    }
    if (grid < 0) return;
    if (hipMemsetAsync(d_ws, 0, 1u << 20, stream) != hipSuccess) { fprintf(stderr, "kernel_launch: hipMemsetAsync failed\n"); return; }
    Params a{};
    for (int i = 0; i < 39; ++i) a.in[i] = (const float*)d_in[i];
    a.out = (float*)d_out; a.ws = (unsigned char*)d_ws;
#if ONE_LAUNCH
    a.ph_lo = 0; a.ph_hi = NPH;
    void* args[] = {&a};
    hipError_t e = hipLaunchCooperativeKernel((const void*)mk_fwd, dim3(grid), dim3(512), args, LDS_BYTES, stream);
    if (e != hipSuccess) fprintf(stderr, "cooperative launch failed: %s (grid %d)\n", hipGetErrorString(e), grid);
#else
    for (int ph = 0; ph < NPH; ++ph) {
        a.ph_lo = ph; a.ph_hi = ph + 1;
        hipLaunchKernelGGL(mk_fwd, dim3(grid), dim3(512), LDS_BYTES, stream, a);
    }
#endif
}
```

```cpp
#include <hip/hip_runtime.h>
#include <hip/hip_cooperative_groups.h>
#include <cstdio>
#include <cstdint>
namespace cg = cooperative_groups;
#ifndef ONE_LAUNCH
#define ONE_LAUNCH 1
#endif
__device__ __forceinline__ int tidx() { int t = threadIdx.x; asm volatile("" : "+v"(t)); return t; }
__device__ __forceinline__ int bidx() { int b = blockIdx.x; asm volatile("" : "+s"(b)); return b; }
namespace pg8 {
#define PG8_LAS __attribute__((address_space(3)))
typedef unsigned short bf16_t;
typedef short bf16x8 __attribute__((ext_vector_type(8)));
typedef float f32x4 __attribute__((ext_vector_type(4)));
typedef unsigned u32x4 __attribute__((ext_vector_type(4)));
constexpr int BM = 256, BK = 64, HALF = 128, HTB = HALF * BK * 2  , STAGE_BYTES = 8 * HTB, NXCD = 8, WGM = 8;

__host__ __device__ __forceinline__ int lds_byte(int r, int c) { const int st = (r >> 4) * 2 + (c >> 5), rr = r & 15, cc = c & 31, ob = rr * 64 + cc * 2; return st * 1024 + (ob ^ (((ob >> 9) & 1) << 5)); }
__host__ __device__ __forceinline__ void stage_rc(int b, int& R, int& C) { const int st = b / 1024, sb = b % 1024, swz = sb ^ (((sb >> 9) & 1) << 5); R = (st >> 1) * 16 + swz / 64; C = (st & 1) * 32 + (swz % 64) / 2; }
__host__ __device__ __forceinline__ int perm32(int rho) { const int n = rho >> 4, i = rho & 15; return 8 * (i >> 2) + 4 * n + (i & 3); }

struct Unit { int pm, pn; };
struct Gemm { const bf16_t* A; const bf16_t* Bt; int M, N, K; };

struct StaticOrder {
    int nM, nN, nwg, G, c;
    __host__ __device__ void init(int M, int N, int G_, int c_) { nM = M / BM; nN = N / BM; nwg = nM * nN; G = G_; c = c_; }
    __host__ __device__ bool next(int i, Unit& u) const {
        const long L = (long)i * G + c; if (L >= nwg) return false;
        int wgid = (int)L; { const int q = nwg / NXCD, r = nwg % NXCD, xcd = wgid % NXCD, off = wgid / NXCD; wgid = (xcd < r ? xcd * (q + 1) : r * (q + 1) + (xcd - r) * q) + off; }
        const int wgm = (nN == 8) ? 4 : WGM;
        const int nig = wgm * nN, gid = wgid / nig, fm = gid * wgm, gsz = (nM - fm) < wgm ? (nM - fm) : wgm;
        u.pm = fm + ((wgid % nig) % gsz); u.pn = (wgid % nig) / gsz; return true;
    }
    __device__ __forceinline__ void a_ready(const Unit&) const {}
    __device__ __forceinline__ void done(const Unit&) const {}
};

__device__ __forceinline__ unsigned cvt_pk_bf16(float lo, float hi) { unsigned r; asm volatile("v_cvt_pk_bf16_f32 %0, %1, %2" : "=v"(r) : "v"(lo), "v"(hi)); return r; }
typedef float f32x2 __attribute__((ext_vector_type(2)));

template <class Epi, class Sched, bool ALIGN_EPI = false, bool SP2 = false>
__device__ __forceinline__ void gemm_phase(PG8_LAS unsigned char* lds, const Gemm g, const Sched& S, const Epi& E) {
    const int tid = tidx(), wid = __builtin_amdgcn_readfirstlane(tid >> 6), lane = tid & 63, wr = wid >> 2, wc = wid & 3, fr = lane & 15, fq = lane >> 4;
    const int K = g.K, nt = K / BK;
    unsigned voffA[2], voffB[2];
#pragma unroll
    for (int i = 0; i < 2; ++i) { int R, C; stage_rc(tid * 16 + i * 8192, R, C); const int Rb = Epi::PERM ? ((R & ~31) + perm32(R & 31)) : R;
        voffA[i] = (unsigned)(R * K + C) * 2u; voffB[i] = (unsigned)(Rb * K + C) * 2u; }
    const size_t kstep = (size_t)(BK * 2);
    const size_t hstep = (size_t)HALF * K * 2;
    const size_t tstep = 2 * hstep;
    const unsigned ldsw = (unsigned)wid * 1024u;
    const int aoff = lds_byte(wr * 64 + fr, fq * 8), boff = lds_byte(wc * 32 + fr, fq * 8);
#define PG8_SA(b, h) (((b) * 2 + (h)) * HTB)
#define PG8_SB(b, h) ((4 + (b) * 2 + (h)) * HTB)
#define PG8_STAGE(bufoff, gbase, voff) do { _Pragma("unroll") for (int _i = 0; _i < 2; ++_i) \
        __builtin_amdgcn_global_load_lds((const unsigned*)((const char*)(gbase) + (voff)[_i]), (PG8_LAS unsigned*)(lds + (bufoff) + ldsw + _i * 8192), 16, 0, 0); } while (0)
#define PG8_LDA(dst, b, h) do { _Pragma("unroll") for (int m = 0; m < 4; ++m) _Pragma("unroll") for (int k = 0; k < 2; ++k) dst[m][k] = *(const PG8_LAS bf16x8*)(lds + PG8_SA(b, h) + aoff + m * 2048 + k * 1024); } while (0)
#define PG8_LDB(dst, b, h) do { _Pragma("unroll") for (int n = 0; n < 2; ++n) _Pragma("unroll") for (int k = 0; k < 2; ++k) dst[n][k] = *(const PG8_LAS bf16x8*)(lds + PG8_SB(b, h) + boff + n * 2048 + k * 1024); } while (0)
#define PG8_MMA(ai, bj, At, Bt) do { __builtin_amdgcn_s_setprio(1); _Pragma("unroll") for (int m = 0; m < 4; ++m) _Pragma("unroll") for (int n = 0; n < 2; ++n) _Pragma("unroll") for (int k = 0; k < 2; ++k) \
        acc[ai][bj][m][n] = __builtin_amdgcn_mfma_f32_16x16x32_bf16(Bt[n][k], At[m][k], acc[ai][bj][m][n], 0, 0, 0); __builtin_amdgcn_s_setprio(0); } while (0)
#define PG8_WAIT_V(n) asm volatile("s_waitcnt vmcnt(" #n ")" ::: "memory")
#define PG8_WAIT_L(n) asm volatile("s_waitcnt lgkmcnt(" #n ")" ::: "memory")
#define PG8_BAR __builtin_amdgcn_s_barrier()
#define PG8_SCHED __builtin_amdgcn_sched_barrier(0)
    Unit cur, nxt; int ui = 0;
    if (!S.next(0, cur)) return;
    f32x4 acc[2][2][4][2];
#pragma unroll
    for (int a = 0; a < 2; ++a)
#pragma unroll
        for (int b = 0; b < 2; ++b)
#pragma unroll
            for (int m = 0; m < 4; ++m)
#pragma unroll
                for (int n = 0; n < 2; ++n) acc[a][b][m][n] = (f32x4){0.f, 0.f, 0.f, 0.f};
    bf16x8 At[4][2], B0[2][2], B1[2][2];
    const char* cA = (const char*)g.A + (size_t)cur.pm * tstep; const char* cB = (const char*)g.Bt + (size_t)cur.pn * tstep;
    S.a_ready(cur);
    if constexpr (SP2) {
        PG8_STAGE(PG8_SB(0, 0), cB, voffB); PG8_STAGE(PG8_SB(0, 1), cB + hstep, voffB); PG8_STAGE(PG8_SA(0, 0), cA, voffA); PG8_STAGE(PG8_SA(0, 1), cA + hstep, voffA);
        if (wr == 1) PG8_BAR;
        PG8_WAIT_V(2); PG8_BAR;
        PG8_STAGE(PG8_SB(1, 0), cB + kstep, voffB); PG8_STAGE(PG8_SA(1, 0), cA + kstep, voffA); PG8_STAGE(PG8_SB(1, 1), cB + hstep + kstep, voffB);
        PG8_WAIT_V(6); PG8_BAR;
    } else {
        PG8_STAGE(PG8_SB(0, 0), cB, voffB); PG8_STAGE(PG8_SA(0, 0), cA, voffA); PG8_STAGE(PG8_SB(0, 1), cB + hstep, voffB); PG8_STAGE(PG8_SA(0, 1), cA + hstep, voffA);
        if (wr == 1) PG8_BAR;
        PG8_WAIT_V(4); PG8_BAR;
        PG8_STAGE(PG8_SB(1, 0), cB + kstep, voffB); PG8_STAGE(PG8_SA(1, 0), cA + kstep, voffA); PG8_STAGE(PG8_SB(1, 1), cB + hstep + kstep, voffB);
        PG8_WAIT_V(6); PG8_BAR;
    }
    for (;;) {
        const bool has_next = S.next(ui + 1, nxt);
        const char* nA = has_next ? (const char*)g.A + (size_t)nxt.pm * tstep : cA; const char* nB = has_next ? (const char*)g.Bt + (size_t)nxt.pn * tstep : cB;
        for (int t = 0; t < nt; t += 2) {
            const bool last = (t == nt - 2);
            const char* a1 = cA + (size_t)(t + 1) * kstep;
            const char* a2 = last ? nA : cA + (size_t)(t + 2) * kstep; const char* b2 = last ? nB : cB + (size_t)(t + 2) * kstep;
            const char* a3 = a2 + kstep; const char* b3 = b2 + kstep;
            if (last && has_next) S.a_ready(nxt);
            if constexpr (SP2) {
            PG8_LDB(B0, 0, 0); PG8_LDB(B1, 0, 1); PG8_SCHED; PG8_LDA(At, 0, 0); PG8_STAGE(PG8_SA(1, 1), a1 + hstep, voffA);
            PG8_WAIT_V(8); PG8_WAIT_L(0); PG8_BAR; PG8_MMA(0, 0, At, B0); PG8_MMA(0, 1, At, B1); PG8_BAR; PG8_SCHED;
            PG8_LDA(At, 0, 1); PG8_STAGE(PG8_SB(0, 0), b2, voffB); PG8_STAGE(PG8_SB(0, 1), b2 + hstep, voffB); PG8_STAGE(PG8_SA(0, 0), a2, voffA);
            PG8_WAIT_V(8); PG8_WAIT_L(0); PG8_BAR; PG8_MMA(1, 0, At, B0); PG8_MMA(1, 1, At, B1); PG8_BAR; PG8_SCHED;
            PG8_LDB(B0, 1, 0); PG8_LDB(B1, 1, 1); PG8_SCHED; PG8_LDA(At, 1, 0); PG8_STAGE(PG8_SA(0, 1), a2 + hstep, voffA);
            PG8_WAIT_V(8); PG8_WAIT_L(0); PG8_BAR; PG8_MMA(0, 0, At, B0); PG8_MMA(0, 1, At, B1); PG8_BAR; PG8_SCHED;
            PG8_LDA(At, 1, 1); PG8_STAGE(PG8_SB(1, 0), b3, voffB); PG8_STAGE(PG8_SB(1, 1), b3 + hstep, voffB); PG8_STAGE(PG8_SA(1, 0), a3, voffA);
            PG8_WAIT_V(8); PG8_WAIT_L(0); PG8_BAR; PG8_MMA(1, 0, At, B0); PG8_MMA(1, 1, At, B1); PG8_BAR; PG8_SCHED;
            } else {
            PG8_LDB(B0, 0, 0); PG8_SCHED; PG8_LDA(At, 0, 0); PG8_STAGE(PG8_SA(1, 1), a1 + hstep, voffA);
            PG8_WAIT_L(8); PG8_BAR; PG8_WAIT_L(0); PG8_MMA(0, 0, At, B0); PG8_BAR; PG8_SCHED;
            PG8_LDB(B1, 0, 1); PG8_STAGE(PG8_SB(0, 0), b2, voffB);
            PG8_BAR; PG8_WAIT_L(0); PG8_MMA(0, 1, At, B1); PG8_BAR;
            PG8_LDA(At, 0, 1); PG8_STAGE(PG8_SA(0, 0), a2, voffA);
            PG8_BAR; PG8_WAIT_L(0); PG8_MMA(1, 0, At, B0); PG8_BAR; PG8_SCHED;
            PG8_STAGE(PG8_SB(0, 1), b2 + hstep, voffB);
            PG8_WAIT_V(6); PG8_BAR; PG8_MMA(1, 1, At, B1); PG8_BAR;
            PG8_LDB(B0, 1, 0); PG8_SCHED; PG8_LDA(At, 1, 0); PG8_STAGE(PG8_SA(0, 1), a2 + hstep, voffA);
            PG8_WAIT_L(8); PG8_BAR; PG8_WAIT_L(0); PG8_MMA(0, 0, At, B0); PG8_BAR; PG8_SCHED;
            PG8_LDB(B1, 1, 1); PG8_STAGE(PG8_SB(1, 0), b3, voffB);
            PG8_BAR; PG8_WAIT_L(0); PG8_MMA(0, 1, At, B1); PG8_BAR;
            PG8_LDA(At, 1, 1); PG8_STAGE(PG8_SA(1, 0), a3, voffA);
            PG8_BAR; PG8_WAIT_L(0); PG8_MMA(1, 0, At, B0); PG8_BAR; PG8_SCHED;
            PG8_STAGE(PG8_SB(1, 1), b3 + hstep, voffB);
            PG8_WAIT_V(6); PG8_BAR; PG8_MMA(1, 1, At, B1); PG8_BAR;
            }
        }
        if constexpr (ALIGN_EPI) { if (wr == 0) PG8_BAR; }
        if constexpr (!Epi::AFTER_DRAIN) { E(acc, cur, wr, wc, fr, fq); S.done(cur); }
        if (!has_next) break;
#pragma unroll
        for (int a = 0; a < 2; ++a)
#pragma unroll
            for (int b = 0; b < 2; ++b)
#pragma unroll
                for (int m = 0; m < 4; ++m)
#pragma unroll
                    for (int n = 0; n < 2; ++n) acc[a][b][m][n] = (f32x4){0.f, 0.f, 0.f, 0.f};
        cur = nxt; cA = nA; cB = nB; ++ui;
        if constexpr (ALIGN_EPI) { if (wr == 1) PG8_BAR; }
    }
    PG8_WAIT_V(0);
    if constexpr (!ALIGN_EPI) { if (wr == 0) PG8_BAR; }
    PG8_BAR;
    if constexpr (Epi::AFTER_DRAIN) { E.fused(acc, cur, wr, wc, fr, fq, lds, wid, lane); S.done(cur); }
#undef PG8_SA
#undef PG8_SB
#undef PG8_STAGE
#undef PG8_LDA
#undef PG8_LDB
#undef PG8_MMA
#undef PG8_WAIT_V
#undef PG8_WAIT_L
#undef PG8_BAR
#undef PG8_SCHED
}
}
using pg8::bf16_t; using pg8::bf16x8; using pg8::f32x4; using pg8::u32x4; using pg8::Unit; using pg8::cvt_pk_bf16;
#define LAS __attribute__((address_space(3)))
typedef float f32x2 __attribute__((ext_vector_type(2)));
typedef unsigned u32x2 __attribute__((ext_vector_type(2)));
typedef short bf16x4 __attribute__((ext_vector_type(4)));
#define WAVE_SYNC() asm volatile("s_waitcnt lgkmcnt(0)" ::: "memory")

constexpr int MT = 8192, SEQ = 4096, DM = 2048, FF = 5504, INC = 5376, RWC = 2560;
constexpr int NPL = 16, NPH = 1 + 2 * NPL;
constexpr int LDS_BYTES = 147456;
constexpr size_t MiB = 1u << 20;
constexpr size_t SZ_WGU = (size_t)11008 * 2048 * 2, SZ_WD = (size_t)2048 * 5504 * 2, SZ_WIN = (size_t)5376 * 2048 * 2, SZ_WOUT = (size_t)2048 * 2048 * 2;
constexpr size_t SZ_WLORA = (size_t)2304 * 256 * 2, SZ_WGLU = (size_t)512 * 512 * 2, SZ_S5TAB = (size_t)(32 * 64 * 2 + 32 * 64 * 32) * 4;
constexpr size_t WS_WGU = 1 * MiB;
constexpr size_t WS_WD = WS_WGU + 4 * SZ_WGU;
constexpr size_t WS_WIN = WS_WD + 4 * SZ_WD;
constexpr size_t WS_WOUT = WS_WIN + 2 * SZ_WIN;
constexpr size_t WS_WLORA = WS_WOUT + 2 * SZ_WOUT;
constexpr size_t WS_WGLU = WS_WLORA + 2 * SZ_WLORA;
constexpr size_t WS_S5TAB = WS_WGLU + 2 * SZ_WGLU;
constexpr size_t WS_XB = ((WS_S5TAB + 2 * SZ_S5TAB + MiB - 1) / MiB) * MiB;
constexpr size_t WS_RS = WS_XB + 32 * MiB;
constexpr size_t WS_YCAT = WS_RS + 1 * MiB;
constexpr size_t WS_BIG = WS_YCAT + 32 * MiB;
constexpr size_t WS_ACT = WS_BIG, WS_H = WS_BIG + 96 * MiB;
constexpr size_t WS_ZR = WS_BIG, WS_DAQK = WS_BIG + 80 * MiB, WS_VT = WS_BIG + 104 * MiB, WS_ZS = WS_BIG + 116 * MiB, WS_LA = WS_BIG + 132 * MiB;
constexpr size_t WS_LR = WS_BIG + 136 * MiB, WS_SEND = WS_BIG + 208 * MiB, WS_SIN = WS_BIG + 232 * MiB;
constexpr size_t WS_YS = WS_BIG + 244 * MiB, WS_YSB = WS_BIG + 260 * MiB, WS_XE = WS_BIG + 268 * MiB, WS_XIN = WS_BIG + 269 * MiB;
constexpr size_t WS_YL = WS_BIG + 172 * MiB, WS_BON = WS_BIG + 196 * MiB, WS_QQ = WS_BIG + 270 * MiB, WS_END = WS_BIG + 294 * MiB;
static_assert(WS_END <= 700 * MiB, "workspace budget");

struct Params { const float* in[39]; float* out; unsigned char* ws; int ph_lo, ph_hi; };

#define DPPF(v, ctrl) __builtin_bit_cast(float, __builtin_amdgcn_mov_dpp(__builtin_bit_cast(int, (v)), (ctrl), 0xf, 0xf, true))
__device__ __forceinline__ float wave_sum(float v) {
    v += DPPF(v, 0xB1); v += DPPF(v, 0x4E); v += DPPF(v, 0x124); v += DPPF(v, 0x128);
    const float r0 = __builtin_bit_cast(float, __builtin_amdgcn_readlane(__builtin_bit_cast(int, v), 0)), r1 = __builtin_bit_cast(float, __builtin_amdgcn_readlane(__builtin_bit_cast(int, v), 16));
    const float r2 = __builtin_bit_cast(float, __builtin_amdgcn_readlane(__builtin_bit_cast(int, v), 32)), r3 = __builtin_bit_cast(float, __builtin_amdgcn_readlane(__builtin_bit_cast(int, v), 48));
    return (r0 + r1) + (r2 + r3);
}
__device__ __forceinline__ float sigmoidf_(float x) { return __builtin_amdgcn_rcpf(1.0f + __expf(-x)); }
__device__ __forceinline__ float dot4(f32x4 a, f32x4 b) { return (a.x * b.x + a.y * b.y) + (a.z * b.z + a.w * b.w); }

struct EpiGU {
    static constexpr bool PERM = true, AFTER_DRAIN = false;
    bf16_t* ACT; const float* rs;
    __device__ __forceinline__ void operator()(const f32x4 (&acc)[2][2][4][2], const Unit& u, int wr, int wc, int fr, int fq) const {
        const int row0 = u.pm * 256 + wr * 64 + fr, col0 = u.pn * 128 + wc * 32 + fq * 8;
        float sv[2][4];
#pragma unroll
        for (int ai = 0; ai < 2; ++ai)
#pragma unroll
            for (int m = 0; m < 4; ++m) sv[ai][m] = rs[row0 + ai * 128 + m * 16];
#pragma unroll
        for (int ai = 0; ai < 2; ++ai)
#pragma unroll
            for (int m = 0; m < 4; ++m) {
                const int row = row0 + ai * 128 + m * 16; const float s = sv[ai][m];
                float o[8];
#pragma unroll
                for (int n = 0; n < 2; ++n)
#pragma unroll
                    for (int j = 0; j < 4; ++j) { const float g = acc[ai][0][m][n][j] * s, up = acc[ai][1][m][n][j] * s; o[n * 4 + j] = g * sigmoidf_(g) * up; }
                u32x4 w; w.x = cvt_pk_bf16(o[0], o[1]); w.y = cvt_pk_bf16(o[2], o[3]); w.z = cvt_pk_bf16(o[4], o[5]); w.w = cvt_pk_bf16(o[6], o[7]);
                *(u32x4*)(ACT + (size_t)row * FF + col0) = w;
            }
    }
};
#define BF2F(x) __builtin_bit_cast(float, ((unsigned)(x)) << 16)
struct EpiBF {
    static constexpr bool PERM = true, AFTER_DRAIN = false;
    bf16_t* C; int ldc;
    __device__ __forceinline__ void operator()(const f32x4 (&acc)[2][2][4][2], const Unit& u, int wr, int wc, int fr, int fq) const {
        const int row0 = u.pm * 256 + wr * 64 + fr, col0 = u.pn * 256 + wc * 32 + fq * 8;
#pragma unroll
        for (int ai = 0; ai < 2; ++ai)
#pragma unroll
            for (int m = 0; m < 4; ++m)
#pragma unroll
                for (int bj = 0; bj < 2; ++bj) {
                    const f32x4 v0 = acc[ai][bj][m][0], v1 = acc[ai][bj][m][1];
                    u32x4 w; w.x = cvt_pk_bf16(v0[0], v0[1]); w.y = cvt_pk_bf16(v0[2], v0[3]); w.z = cvt_pk_bf16(v1[0], v1[1]); w.w = cvt_pk_bf16(v1[2], v1[3]);
                    *(u32x4*)(C + (size_t)(row0 + ai * 128 + m * 16) * ldc + col0 + bj * 128) = w;
                }
    }
};
struct EpiIN {
    static constexpr bool PERM = true, AFTER_DRAIN = false;
    float* ZR; bf16_t* DAQK; bf16_t* VT; float* ZS; const float* rs;
    __device__ __forceinline__ void operator()(const f32x4 (&acc)[2][2][4][2], const Unit& u, int wr, int wc, int fr, int fq) const {
        const int row0 = u.pm * 256 + wr * 64 + fr, cl0 = wc * 32 + fq * 8; const int pn = u.pn;
        float sv[2][4];
#pragma unroll
        for (int ai = 0; ai < 2; ++ai)
#pragma unroll
            for (int m = 0; m < 4; ++m) sv[ai][m] = rs[row0 + ai * 128 + m * 16];
#pragma unroll
        for (int ai = 0; ai < 2; ++ai)
#pragma unroll
            for (int m = 0; m < 4; ++m) {
                const int row = row0 + ai * 128 + m * 16; const float s = sv[ai][m];
#pragma unroll
                for (int bj = 0; bj < 2; ++bj) {
                    const f32x4 v0 = acc[ai][bj][m][0] * s, v1 = acc[ai][bj][m][1] * s; const int cl = cl0 + bj * 128;
                    if (pn < 10) { float* p = ZR + (size_t)row * RWC + pn * 256 + cl; *(f32x4*)p = v0; *(f32x4*)(p + 4) = v1; }
                    else if (pn < 16) { const float sc = (pn < 13) ? 0.18033688011112042f : 1.0f;
                        u32x4 w; w.x = cvt_pk_bf16(v0[0] * sc, v0[1] * sc); w.y = cvt_pk_bf16(v0[2] * sc, v0[3] * sc); w.z = cvt_pk_bf16(v1[0] * sc, v1[1] * sc); w.w = cvt_pk_bf16(v1[2] * sc, v1[3] * sc);
                        *(u32x4*)(DAQK + (size_t)row * 1536 + (pn - 10) * 256 + cl) = w; }
                    else if (pn < 19) { const int b = row >> 12, t = row & 4095; bf16_t* p = VT + ((size_t)(b * 768 + (pn - 16) * 256 + cl)) * SEQ + t;
#pragma unroll
                        for (int j = 0; j < 4; ++j) { p[(size_t)j * SEQ] = (bf16_t)(cvt_pk_bf16(v0[j], 0.f) & 0xffffu); p[(size_t)(j + 4) * SEQ] = (bf16_t)(cvt_pk_bf16(v1[j], 0.f) & 0xffffu); } }
                    else { float* p = ZS + (size_t)row * 512 + (pn - 19) * 256 + cl; *(f32x4*)p = v0; *(f32x4*)(p + 4) = v1; }
                }
            }
    }
};
__device__ __forceinline__ float decay_of(float x) {
    return __expf(-0.6065306597126334f * sigmoidf_(x));
}
struct EpiGLU {
    static constexpr bool PERM = true, AFTER_DRAIN = false;
    bf16_t* YCAT; const float* YS; const float* bglu;
    __device__ __forceinline__ void operator()(const f32x4 (&acc)[2][2][4][2], const Unit& u, int wr, int wc, int fr, int fq) const {
        const int row0 = u.pm * 256 + wr * 64 + fr, col0 = u.pn * 256 + wc * 32 + fq * 8;
#pragma unroll
        for (int bj = 0; bj < 2; ++bj) {
            const int c = col0 + bj * 128;
            const f32x4 b0 = *(const f32x4*)(bglu + c), b1 = *(const f32x4*)(bglu + c + 4);
#pragma unroll
            for (int ai = 0; ai < 2; ++ai)
#pragma unroll
                for (int m = 0; m < 4; ++m) {
                    const int row = row0 + ai * 128 + m * 16;
                    const f32x4 y0 = *(const f32x4*)(YS + (size_t)row * 512 + c), y1 = *(const f32x4*)(YS + (size_t)row * 512 + c + 4);
                    const f32x4 a0 = acc[ai][bj][m][0] + b0, a1 = acc[ai][bj][m][1] + b1;
                    float o[8];
#pragma unroll
                    for (int j = 0; j < 4; ++j) { o[j] = y0[j] * sigmoidf_(a0[j]); o[4 + j] = y1[j] * sigmoidf_(a1[j]); }
                    u32x4 w; w.x = cvt_pk_bf16(o[0], o[1]); w.y = cvt_pk_bf16(o[2], o[3]); w.z = cvt_pk_bf16(o[4], o[5]); w.w = cvt_pk_bf16(o[6], o[7]);
                    *(u32x4*)(YCAT + (size_t)row * DM + 1536 + c) = w;
                }
        }
    }
};
__device__ __forceinline__ void transpose_tile(const float* src, int ld, int K, const float* gvec, bf16_t* dst, int kt, int nt, int mode, LAS float* tl) {
    const int tid = tidx(); const int k0 = kt * 128, n0 = nt * 256;
    f32x4 v[16];
    const int j = (tid & 63) * 4; const int sc = (mode == 1) ? ((j < 128) ? nt * 128 + j : FF + nt * 128 + j - 128) : n0 + j;
    const float* sp = src + (size_t)(k0 + (tid >> 6)) * ld + sc;
#pragma unroll
    for (int i = 0; i < 16; ++i) v[i] = *(const f32x4*)(sp + (size_t)(8 * i) * ld);
#pragma unroll
    for (int i = 0; i < 16; ++i) {
        const int row = (tid >> 6) + 8 * i;
        const float g = gvec ? gvec[k0 + row] : 1.f;
        const int sw = ((row >> 3) & 15) << 1; LAS float* q = tl + row * 256;
        q[(j) ^ sw] = v[i].x * g; q[(j + 1) ^ sw] = v[i].y * g; q[(j + 2) ^ sw] = v[i].z * g; q[(j + 3) ^ sw] = v[i].w * g;
    }
    __syncthreads();
#pragma unroll
    for (int jj = 0; jj < 8; ++jj) {
        const int c = tid + 512 * jj; const int n = c >> 4, kc = c & 15;
        float x[8];
#pragma unroll
        for (int i = 0; i < 8; ++i) x[i] = tl[(kc * 8 + i) * 256 + (n ^ (kc << 1))];
        u32x4 w; w.x = cvt_pk_bf16(x[0], x[1]); w.y = cvt_pk_bf16(x[2], x[3]); w.z = cvt_pk_bf16(x[4], x[5]); w.w = cvt_pk_bf16(x[6], x[7]);
        *(u32x4*)(dst + (size_t)(n0 + n) * K + k0 + kc * 8) = w;
    }
    __syncthreads();
}

__device__ __forceinline__ void row_phase(const bf16_t* H, const float* xin, float* Xout, bf16_t* XB, float* RS, const float* g, float c, int wave, int lane, int m_begin = -1, int m_count = 0) {
    const int mb = (m_begin < 0) ? bidx() * 8 + wave : m_begin + wave, me = (m_begin < 0) ? MT : m_begin + m_count, mstep = (m_begin < 0) ? gridDim.x * 8 : 8;
#define BFX4(w) (f32x4){__builtin_bit_cast(float, (w).x << 16), __builtin_bit_cast(float, (w).x & 0xffff0000u), __builtin_bit_cast(float, (w).y << 16), __builtin_bit_cast(float, (w).y & 0xffff0000u)}
    if (H) {
        for (int m = mb; m < me; m += 2 * mstep) {
            const int m2 = (m + mstep < me) ? m + mstep : m;
            u32x2 hw[2][8], xw[2][8];
#pragma unroll
            for (int i = 0; i < 8; ++i) { const int o = (lane + 64 * i) * 4;
                hw[0][i] = *(const u32x2*)(H + (size_t)m * DM + o); xw[0][i] = *(const u32x2*)(XB + (size_t)m * DM + o);
                hw[1][i] = *(const u32x2*)(H + (size_t)m2 * DM + o); xw[1][i] = *(const u32x2*)(XB + (size_t)m2 * DM + o); }
#pragma unroll
            for (int r = 0; r < 2; ++r) {
                const int mr = r ? m2 : m;
                if (r == 1 && m2 == m) break;
                float ss = 0.f;
#pragma unroll
                for (int i = 0; i < 8; ++i) { const f32x4 hh = BFX4(hw[r][i]); ss += dot4(hh, hh); }
                ss = wave_sum(ss); const float rstd = rsqrtf(ss * (1.0f / DM) + 1e-6f) * c;
                float s2 = 0.f;
#pragma unroll
                for (int i = 0; i < 8; ++i) {
                    const size_t o = (size_t)mr * DM + (lane + 64 * i) * 4;
                    const f32x4 hh = BFX4(hw[r][i]); f32x4 x = BFX4(xw[r][i]);
                    const f32x4 gg = *(const f32x4*)(g + (lane + 64 * i) * 4); x = x + hh * rstd * gg;
                    if (Xout) *(f32x4*)(Xout + o) = x;
                    s2 += dot4(x, x);
                    u32x2 w; w.x = cvt_pk_bf16(x.x, x.y); w.y = cvt_pk_bf16(x.z, x.w); *(u32x2*)(XB + o) = w;
                }
                s2 = wave_sum(s2);
                if (lane == 0) RS[mr] = rsqrtf(s2 * (1.0f / DM) + 1e-6f);
            }
        }
    } else {
        for (int m = mb; m < me; m += mstep) {
            float s2 = 0.f;
#pragma unroll
            for (int i = 0; i < 8; ++i) {
                const size_t o = (size_t)m * DM + (lane + 64 * i) * 4;
                const f32x4 x = *(const f32x4*)(xin + o);
                if (Xout) *(f32x4*)(Xout + o) = x;
                s2 += dot4(x, x);
                u32x2 w; w.x = cvt_pk_bf16(x.x, x.y); w.y = cvt_pk_bf16(x.z, x.w); *(u32x2*)(XB + o) = w;
            }
            s2 = wave_sum(s2);
            if (lane == 0) RS[m] = rsqrtf(s2 * (1.0f / DM) + 1e-6f);
        }
    }
#undef BFX4
}

__device__ __forceinline__ void weight_tile(const Params& p, int gt, LAS unsigned char* lds) {
    unsigned char* ws = p.ws;
    const int l = gt / 2536; int r = gt - l * 2536;
    const float* src; int ld, K, ntn, mode = 0; const float* gv = nullptr; bf16_t* dst;
    if (r < 1376) { const int which = r >= 688; r -= which * 688; src = p.in[which ? 36 : 2] + (size_t)l * DM * 2 * FF; ld = 2 * FF; K = DM; ntn = 43; mode = 1; gv = p.in[which ? 35 : 1] + l * DM; dst = (bf16_t*)(ws + WS_WGU + (size_t)(l * 2 + which) * SZ_WGU); }
    else if (r < 2064) { r -= 1376; const int which = r >= 344; r -= which * 344; src = p.in[which ? 37 : 3] + (size_t)l * FF * DM; ld = DM; K = FF; ntn = 8; dst = (bf16_t*)(ws + WS_WD + (size_t)(l * 2 + which) * SZ_WD); }
    else if (r < 2400) { r -= 2064; src = p.in[6] + (size_t)l * DM * INC; ld = INC; K = DM; ntn = 21; gv = p.in[5] + l * DM; dst = (bf16_t*)(ws + WS_WIN + (size_t)l * SZ_WIN); }
    else if (r < 2528) { r -= 2400; src = p.in[33] + (size_t)l * DM * DM; ld = DM; K = DM; ntn = 8; dst = (bf16_t*)(ws + WS_WOUT + (size_t)l * SZ_WOUT); }
    else { r -= 2528; src = p.in[31] + (size_t)l * 512 * 512; ld = 512; K = 512; ntn = 2; dst = (bf16_t*)(ws + WS_WGLU + (size_t)l * SZ_WGLU); }
    const int kt = r / ntn, nt = r - kt * ntn;
    transpose_tile(src, ld, K, gv, dst, kt, nt, mode, (LAS float*)lds);
}

__device__ __forceinline__ void prologue(const Params& p, LAS unsigned char* lds, int wave, int lane) {
    unsigned char* ws = p.ws; const int tid = tidx(); const int G = gridDim.x;
    for (int gt = bidx(); gt < 2 * 2536 - 1376; gt += G) weight_tile(p, (gt < 2536) ? gt : gt + 1376, lds);
    if (bidx() == 0) ((unsigned*)ws)[tid] = 0u;
    for (int idx = bidx() * 512 + tid; idx < 2 * 2304 * 256; idx += G * 512) {
        const int l = idx / (2304 * 256); const int r = idx - l * (2304 * 256); const int n = r >> 8, k = r & 255;
        float v = 0.f;
        if (n < 768) { if (k < 64) v = p.in[9][((size_t)l * 64 + k) * 768 + n]; }
        else if (n < 1536) { if (k >= 64 && k < 128) v = p.in[11][((size_t)l * 64 + (k - 64)) * 768 + (n - 768)]; }
        else { if (k >= 128) v = p.in[12][((size_t)l * 128 + (k - 128)) * 768 + (n - 1536)]; }
        ((bf16_t*)(ws + WS_WLORA))[idx] = (bf16_t)(cvt_pk_bf16(v, 0.f) & 0xffffu);
    }
    for (int idx = bidx() * 512 + tid; idx < 2 * 2048; idx += G * 512) {
        const int l = idx >> 11, gn = idx & 2047, g = gn >> 6;
        float* tab = (float*)(ws + WS_S5TAB + (size_t)l * SZ_S5TAB);
        const float dt = expf(p.in[25][l * 32 + g]); const float ar = p.in[23][l * 2048 + gn], ai = p.in[24][l * 2048 + gn];
        const float mag = expf(dt * ar); const float abr = mag * cosf(dt * ai), abi = mag * sinf(dt * ai);
        const float den = ar * ar + ai * ai; const float nr = abr - 1.0f, ni = abi;
        const float cr = (nr * ar + ni * ai) / den, ci = (ni * ar - nr * ai) / den;
        tab[gn * 2] = abr; tab[gn * 2 + 1] = abi;
        const float* br = p.in[26] + ((size_t)l * 2048 + gn) * 16; const float* bi = p.in[27] + ((size_t)l * 2048 + gn) * 16;
#pragma unroll
        for (int c = 0; c < 16; ++c) { tab[4096 + gn * 32 + c * 2] = cr * br[c] - ci * bi[c]; tab[4096 + gn * 32 + c * 2 + 1] = cr * bi[c] + ci * br[c]; }
    }
    row_phase(nullptr, p.in[0], nullptr, (bf16_t*)(ws + WS_XB), (float*)(ws + WS_RS), nullptr, 0.f, wave, lane);
}

__device__ __forceinline__ void la_prep(const Params& p, int l) {
    const float* ZR = (const float*)(p.ws + WS_ZR); bf16_t* LA = (bf16_t*)(p.ws + WS_LA); const float* mu = p.in[7] + l * RWC;
    for (int idx = bidx() * 512 + tidx(); idx < MT * 64; idx += gridDim.x * 512) {
        const int m = idx >> 6, c4 = (idx & 63) * 4; const int col = 2304 + c4;
        const f32x4 zc = *(const f32x4*)(ZR + (size_t)m * RWC + col);
        f32x4 zp = {0.f, 0.f, 0.f, 0.f}; if (m & (SEQ - 1)) zp = *(const f32x4*)(ZR + (size_t)(m - 1) * RWC + col);
        const f32x4 m4 = *(const f32x4*)(mu + col);
        f32x4 z = zc + (zp - zc) * m4;
        if (c4 < 64) { z.x = tanhf(z.x); z.y = tanhf(z.y); z.z = tanhf(z.z); z.w = tanhf(z.w); }
        else if (c4 >= 128) { z.x = sigmoidf_(z.x); z.y = sigmoidf_(z.y); z.z = sigmoidf_(z.z); z.w = sigmoidf_(z.w); }
        u32x2 w; w.x = cvt_pk_bf16(z.x, z.y); w.y = cvt_pk_bf16(z.z, z.w);
        *(u32x2*)(LA + (size_t)m * 256 + c4) = w;
    }
}

__device__ __forceinline__ float gelu_tanh(float x) { const float t = tanhf(0.7978845608028654f * (x + 0.044715f * x * x * x)); return 0.5f * x * (1.0f + t); }

template <int PASS>
__device__ __forceinline__ void s5_scan(const Params& p, int l, int widx, int nw, int beff, int nblk, int lane, LAS unsigned char* lds) {
    if (widx < 0 || widx >= nw || beff < 0) return;
    unsigned char* ws = p.ws;
    LAS float* ub = (LAS float*)(lds + widx * 19456);
    LAS float* xb = ub + 512;
    LAS float* ct = xb + 16 * 132;
    const float* ZS = (const float*)(ws + WS_ZS); const float* tab = (const float*)(ws + WS_S5TAB + (size_t)l * SZ_S5TAB);
    float* XE = (float*)(ws + WS_XE);
    float* YS = (float*)(ws + WS_YS); bf16_t* YSB = (bf16_t*)(ws + WS_YSB);
    for (int u = widx * nblk + beff; u < 1024; u += nw * nblk) {
        const int c = u & 15, g = (u >> 4) & 31, b = u >> 9; const int gn = g * 64 + lane;
        const float ar = tab[gn * 2], ai = tab[gn * 2 + 1];
        float br[16], bi[16];
#pragma unroll
        for (int q = 0; q < 8; ++q) { const f32x4 v = *(const f32x4*)(tab + 4096 + gn * 32 + q * 4); br[2 * q] = v.x; bi[2 * q] = v.y; br[2 * q + 1] = v.z; bi[2 * q + 1] = v.w; }
        float xr = 0.f, xi = 0.f;
        if (PASS == 2) {
            float pr = ar, pi = ai;
#pragma unroll
            for (int i = 0; i < 8; ++i) { const float r2 = pr * pr - pi * pi, i2 = 2.f * pr * pi; pr = r2; pi = i2; }
            for (int cp = 0; cp < c; ++cp) { const int up = (u & ~15) + cp; const float er = XE[(up * 64 + lane) * 2], ei = XE[(up * 64 + lane) * 2 + 1];
                const float nr = pr * xr - pi * xi + er, ni = pr * xi + pi * xr + ei; xr = nr; xi = ni; }
#pragma unroll
            for (int cc = 0; cc < 16; ++cc) { ct[cc * 132 + lane] = p.in[28][((size_t)l * 32 + g) * 1024 + cc * 64 + lane]; ct[cc * 132 + 64 + lane] = -p.in[29][((size_t)l * 32 + g) * 1024 + cc * 64 + lane]; }
        }
        const int m0 = b * SEQ + c * 256;
        f32x4 un = *(const f32x4*)(ZS + (size_t)(m0 + (lane >> 2)) * 512 + g * 16 + (lane & 3) * 4);
        for (int bt = 0; bt < 16; ++bt) {
            LAS float* ubc = ub + (bt & 1) * 256;
            *(LAS f32x4*)(ubc + lane * 4) = un;
            if (bt + 1 < 16) un = *(const f32x4*)(ZS + (size_t)(m0 + (bt + 1) * 16 + (lane >> 2)) * 512 + g * 16 + (lane & 3) * 4);
            WAVE_SYNC();
#pragma unroll 4
            for (int s = 0; s < 16; ++s) {
                const f32x4 u0 = *(LAS f32x4*)(ubc + s * 16), u1 = *(LAS f32x4*)(ubc + s * 16 + 4), u2 = *(LAS f32x4*)(ubc + s * 16 + 8), u3 = *(LAS f32x4*)(ubc + s * 16 + 12);
                float bur = 0.f, bui = 0.f;
#pragma unroll
                for (int j = 0; j < 4; ++j) { bur += br[j] * u0[j]; bui += bi[j] * u0[j]; }
#pragma unroll
                for (int j = 0; j < 4; ++j) { bur += br[4 + j] * u1[j]; bui += bi[4 + j] * u1[j]; }
#pragma unroll
                for (int j = 0; j < 4; ++j) { bur += br[8 + j] * u2[j]; bui += bi[8 + j] * u2[j]; }
#pragma unroll
                for (int j = 0; j < 4; ++j) { bur += br[12 + j] * u3[j]; bui += bi[12 + j] * u3[j]; }
                const float nxr = ar * xr - ai * xi + bur, nxi = ar * xi + ai * xr + bui; xr = nxr; xi = nxi;
                if (PASS == 2) { xb[s * 132 + lane] = xr; xb[s * 132 + 64 + lane] = xi; }
            }
            if (PASS == 2) {
                WAVE_SYNC();
                const int s = lane >> 2, c4 = lane & 3;
                f32x4 y = {0.f, 0.f, 0.f, 0.f};
#pragma unroll 4
                for (int n4 = 0; n4 < 32; ++n4) {
                    const f32x4 xv = *(LAS f32x4*)(xb + s * 132 + n4 * 4);
#pragma unroll
                    for (int j = 0; j < 4; ++j) { const f32x4 cv = *(LAS f32x4*)(ct + (c4 * 4 + j) * 132 + n4 * 4); y[j] += dot4(xv, cv); }
                }
                const f32x4 uu = *(LAS f32x4*)(ubc + s * 16 + c4 * 4);
                const f32x4 dsk = *(const f32x4*)(p.in[30] + l * 512 + g * 16 + c4 * 4);
                y = y + dsk * uu;
                y.x = gelu_tanh(y.x); y.y = gelu_tanh(y.y); y.z = gelu_tanh(y.z); y.w = gelu_tanh(y.w);
                const size_t o = (size_t)(m0 + bt * 16 + s) * 512 + g * 16 + c4 * 4;
                *(f32x4*)(YS + o) = y;
                u32x2 w; w.x = cvt_pk_bf16(y.x, y.y); w.y = cvt_pk_bf16(y.z, y.w); *(u32x2*)(YSB + o) = w;
                WAVE_SYNC();
            }
        }
        if (PASS == 1) { XE[(u * 64 + lane) * 2] = xr; XE[(u * 64 + lane) * 2 + 1] = xi; }
    }
}
__device__ __forceinline__ void s5_combine(const Params& p, int l, int unit0, int ustride, int lane) {
    const float* tab = (const float*)(p.ws + WS_S5TAB + (size_t)l * SZ_S5TAB); const float* XE = (const float*)(p.ws + WS_XE); float* XIN = (float*)(p.ws + WS_XIN);
    for (int bg = unit0; bg < 64; bg += ustride) {
        const int g = bg & 31; float ar = tab[(g * 64 + lane) * 2], ai = tab[(g * 64 + lane) * 2 + 1];
#pragma unroll
        for (int i = 0; i < 8; ++i) { const float r2 = ar * ar - ai * ai, i2 = 2.f * ar * ai; ar = r2; ai = i2; }
        float xr = 0.f, xi = 0.f; asm volatile("" : "+v"(xr), "+v"(xi));
        for (int c = 0; c < 16; ++c) {
            const int u = bg * 16 + c;
            XIN[(u * 64 + lane) * 2] = xr; XIN[(u * 64 + lane) * 2 + 1] = xi;
            const float er = XE[(u * 64 + lane) * 2], ei = XE[(u * 64 + lane) * 2 + 1];
            const float nr = ar * xr - ai * xi + er, ni = ar * xi + ai * xr + ei; xr = nr; xi = ni;
        }
    }
}
template <int PASS>
__device__ __forceinline__ void rwkv_scan(const Params& p, int l, int wave, int lane, LAS unsigned char* lds) {
    if (wave >= 3) return;
    constexpr int NB = 2, NBT = 128 / NB;
    const int G = gridDim.x; unsigned char* ws = p.ws;
    LAS float* sb = (LAS float*)(lds + wave * 8192);
    LAS float* cb = sb + 1024 + lane;
    const float* ZR = (const float*)(ws + WS_ZR); const bf16_t* LR = (const bf16_t*)(ws + WS_LR);
    const float* SIN = (const float*)(ws + WS_SIN); bf16_t* YCAT = (bf16_t*)(ws + WS_YCAT);
    for (int u = wave * G + bidx(); u < 768; u += 3 * G) {
        const int c = u & 31, bh = u >> 5; const int b = bh / 12, h = bh - b * 12; const int ch = h * 64 + lane;
        const int m0 = b * SEQ + c * 128;
        cb[0] = p.in[7][l * RWC + ch]; cb[64] = p.in[7][l * RWC + 768 + ch]; cb[128] = p.in[7][l * RWC + 1536 + ch];
        cb[192] = p.in[13][l * 768 + ch]; cb[256] = p.in[14][l * 768 + ch]; cb[320] = p.in[8][l * 768 + ch]; cb[384] = p.in[10][l * 768 + ch];
        cb[448] = p.in[15][l * 768 + ch];
        if (PASS == 2) { cb[512] = p.in[16][l * 768 + ch]; cb[576] = p.in[17][l * 768 + ch]; }
        f32x2 s[32]; f32x2 pp[32];
        if (PASS == 1) {
#pragma unroll
            for (int j = 0; j < 32; ++j) { int ll = lane; asm volatile("" : "+v"(ll)); s[j] = (f32x2){0.f, 0.f}; pp[j] = (f32x2){(2 * j == ll) ? 1.f : 0.f, (2 * j + 1 == ll) ? 1.f : 0.f}; }
        } else {
#pragma unroll
            for (int j = 0; j < 32; ++j) { s[j] = (f32x2){SIN[((size_t)u * 64 + 2 * j) * 64 + lane], SIN[((size_t)u * 64 + 2 * j + 1) * 64 + lane]}; }
        }
        float pr = 0.f, pk = 0.f, pv = 0.f;
        if (c != 0) { const float* zp = ZR + (size_t)(m0 - 1) * RWC; pr = zp[ch]; pk = zp[768 + ch]; pv = zp[1536 + ch]; }
        float zr4[NB], zk4[NB], zv4[NB], de4[NB], aa4[NB], gg4[NB];
#pragma unroll
        for (int q = 0; q < NB; ++q) { const float* zb = ZR + (size_t)(m0 + q) * RWC; const bf16_t* lb = LR + (size_t)(m0 + q) * 2304; zr4[q] = zb[ch]; zk4[q] = (zb + 768)[ch]; zv4[q] = (zb + 1536)[ch]; de4[q] = BF2F(lb[ch]); aa4[q] = BF2F((lb + 768)[ch]); gg4[q] = (PASS == 2) ? BF2F((lb + 1536)[ch]) : 0.f; }
        for (int bt = 0; bt < NBT; ++bt) {
            float vv[NB];
            const float mu_r = cb[0], mu_k = cb[64], mu_v = cb[128], kkc = cb[192], kac = cb[256], w0c = cb[320], a0c = cb[384]; const float rkc = cb[448];
#pragma unroll
            for (int q = 0; q < NB; ++q) {
                const float r = zr4[q] + (pr - zr4[q]) * mu_r, k = zk4[q] + (pk - zk4[q]) * mu_k, v = zv4[q] + (pv - zv4[q]) * mu_v;
                pr = zr4[q]; pk = zk4[q]; pv = zv4[q];
                float kk = k * kkc; const float n2 = wave_sum(kk * kk); kk = kk * __builtin_amdgcn_rcpf(fmaxf(__builtin_amdgcn_sqrtf(n2), 1e-12f));
                const float a = sigmoidf_(a0c + aa4[q]); const float kmod = k * (1.0f + (a - 1.0f) * kac);
                LAS float* q5 = sb + q * 512 + lane;
                q5[0] = decay_of(w0c + de4[q]); q5[64] = -kk; q5[128] = kk * a; q5[192] = kmod; q5[256] = r; q5[320] = v;
                vv[q] = v;
                if (PASS == 2) { q5[384] = wave_sum(r * kmod * rkc) * v; q5[448] = gg4[q]; }
                if (PASS == 1) { const float bo = wave_sum(r * kmod * rkc) * v; ((bf16_t*)(ws + WS_BON))[(size_t)(m0 + bt * NB + q) * 768 + ch] = (bf16_t)(cvt_pk_bf16(bo, 0.f) & 0xffffu); }
            }
            if (bt + 1 < NBT) {
#pragma unroll
                for (int q = 0; q < NB; ++q) { const float* zb = ZR + (size_t)(m0 + (bt + 1) * NB + q) * RWC; const bf16_t* lb = LR + (size_t)(m0 + (bt + 1) * NB + q) * 2304; zr4[q] = zb[ch]; zk4[q] = (zb + 768)[ch]; zv4[q] = (zb + 1536)[ch]; de4[q] = BF2F(lb[ch]); aa4[q] = BF2F((lb + 768)[ch]); gg4[q] = (PASS == 2) ? BF2F((lb + 1536)[ch]) : 0.f; }
            }
            WAVE_SYNC();
            float yo[NB];
#define SB_ __builtin_amdgcn_sched_barrier(0)
#define LDV(dst, n, src) _Pragma("unroll") for (int j_ = 0; j_ < (n); ++j_) dst[j_] = (src)[j_]
            if (PASS == 1) {
                f32x4 H3[3][4];
#define RW1_VEC(k) (((k) < 4) ? 16 : (((k) >= 16) ? 64 : (((((k) - 4) % 3) == 0) ? 0 : (((((k) - 4) % 3) == 1) ? 32 : 48))))
#define RW1_QTR(k) (((k) < 4) ? (k) : (((k) >= 16) ? ((k) - 16) : (((k) - 4) / 3)))
#define RW1_PTR(g) ((const LAS f32x4*)(sb + ((g) / 20) * 512) + RW1_VEC((g) % 20) + RW1_QTR((g) % 20) * 4)
                LDV(H3[0], 4, RW1_PTR(0)); LDV(H3[1], 4, RW1_PTR(1));
#pragma unroll
                for (int q = 0; q < NB; ++q) {
                    const float vq = sb[q * 512 + 320 + lane];
                    f32x2 as0, ap0, sas2, sap2; const f32x2 v2 = {vq, vq};
#pragma unroll
                    for (int k = 0; k < 20; ++k) {
                        const int g = q * 20 + k; const int c8 = RW1_QTR(k) * 8; const int t = (k < 4) ? -1 : ((k >= 16) ? 3 : ((k - 4) % 3));
                        if (g + 2 < NB * 20) { LDV(H3[(g + 2) % 3], 4, RW1_PTR(g + 2)); }
                        SB_;
#pragma unroll
                        for (int j = 0; j < 4; ++j) {
                            const f32x4 o4 = H3[g % 3][j]; const f32x2 lo = {o4.x, o4.y}, hi = {o4.z, o4.w};
                            if (t < 0) { if (k == 0 && j == 0) { as0 = s[c8] * lo; ap0 = pp[c8] * lo; } else { as0 += s[c8 + 2 * j] * lo; ap0 += pp[c8 + 2 * j] * lo; } as0 += s[c8 + 2 * j + 1] * hi; ap0 += pp[c8 + 2 * j + 1] * hi; }
                            else if (t == 0) { s[c8 + 2 * j] *= lo; s[c8 + 2 * j + 1] *= hi; pp[c8 + 2 * j] *= lo; pp[c8 + 2 * j + 1] *= hi; }
                            else if (t == 1) { s[c8 + 2 * j] += sas2 * lo; s[c8 + 2 * j + 1] += sas2 * hi; pp[c8 + 2 * j] += sap2 * lo; pp[c8 + 2 * j + 1] += sap2 * hi; }
                            else if (t == 2) { s[c8 + 2 * j] += v2 * lo; s[c8 + 2 * j + 1] += v2 * hi; }
                            else { if (k == 16 && j == 0) { as0 = s[c8] * lo; ap0 = pp[c8] * lo; } else { as0 += s[c8 + 2 * j] * lo; ap0 += pp[c8 + 2 * j] * lo; } as0 += s[c8 + 2 * j + 1] * hi; ap0 += pp[c8 + 2 * j + 1] * hi; }
                        }
                        if (k == 19) { const size_t o = (size_t)(m0 + bt * NB + q) * 768 + ch; ((float*)(ws + WS_YL))[o] = as0.x + as0.y; ((float*)(ws + WS_QQ))[o] = ap0.x + ap0.y; }
                        if (k == 3) { const float sas = as0.x + as0.y, sap = ap0.x + ap0.y; sas2 = (f32x2){sas, sas}; sap2 = (f32x2){sap, sap}; }
                        SB_;
                    }
                }
#undef RW1_PTR
#undef RW1_QTR
#undef RW1_VEC
            } else {
                f32x4 H3[2][8];
#define RW2_PTR(g) ((const LAS f32x4*)(sb + ((g) / 10) * 512) + ((((g) % 10) / 2 == 0) ? 16 : ((((g) % 10) / 2 == 1) ? 0 : ((((g) % 10) / 2 == 2) ? 32 : ((((g) % 10) / 2 == 3) ? 48 : 64)))) + ((g) % 2) * 8)
                LDV(H3[0], 8, RW2_PTR(0));
#pragma unroll
                for (int q = 0; q < NB; ++q) {
                    f32x2 as0, as1, ay0, ay1, sas2; const f32x2 v2 = {vv[q], vv[q]};
#pragma unroll
                    for (int k = 0; k < 10; ++k) {
                        const int g = q * 10 + k; const int h16 = (k & 1) * 16;
                        if (g + 1 < NB * 10) { LDV(H3[(g + 1) % 2], 8, RW2_PTR(g + 1)); }
                        SB_;
#pragma unroll
                        for (int j = 0; j < 8; ++j) {
                            const f32x4 o4 = H3[g % 2][j]; const f32x2 lo = {o4.x, o4.y}, hi = {o4.z, o4.w};
                            if (k < 2) { if (k == 0 && j == 0) { as0 = s[0] * lo; as1 = s[1] * hi; } else { as0 += s[h16 + 2 * j] * lo; as1 += s[h16 + 2 * j + 1] * hi; } }
                            else if (k < 4) { s[h16 + 2 * j] *= lo; s[h16 + 2 * j + 1] *= hi; }
                            else if (k < 6) { s[h16 + 2 * j] += sas2 * lo; s[h16 + 2 * j + 1] += sas2 * hi; }
                            else if (k < 8) { s[h16 + 2 * j] += v2 * lo; s[h16 + 2 * j + 1] += v2 * hi; }
                            else { if (k == 8 && j == 0) { ay0 = s[0] * lo; ay1 = s[1] * hi; } else { ay0 += s[h16 + 2 * j] * lo; ay1 += s[h16 + 2 * j + 1] * hi; } }
                        }
                        if (k == 1) { const float sas = (as0.x + as0.y) + (as1.x + as1.y); sas2 = (f32x2){sas, sas}; }
                        SB_;
                    }
                    yo[q] = (ay0.x + ay0.y) + (ay1.x + ay1.y);
                }
#undef RW2_PTR
            }
#undef SB_
#undef LDV
            if (PASS == 2) {
#pragma unroll
                for (int q = 0; q < NB; ++q) {
                    const float mean = wave_sum(yo[q]) * (1.0f / 64.0f); const float d = yo[q] - mean; const float var = wave_sum(d * d) * (1.0f / 64.0f);
                    const float gnw = cb[512], gnb = cb[576]; const float yn = d * rsqrtf(var + 64e-5f) * gnw + gnb; const float o = (yn + sb[q * 512 + 384 + lane]) * sb[q * 512 + 448 + lane];
                    YCAT[(size_t)(m0 + bt * NB + q) * DM + ch] = (bf16_t)(cvt_pk_bf16(o, 0.f) & 0xffffu);
                }
            }
            WAVE_SYNC();
        }
        if (PASS == 1) {
            int ll = lane; asm volatile("" : "+v"(ll));
            unsigned char* wsl = p.ws; asm volatile("" : "+s"(wsl)); int ul = u; asm volatile("" : "+s"(ul));
            float* sp = (float*)(wsl + WS_SEND) + (size_t)ul * 8192 + ll;
#pragma unroll
            for (int j = 0; j < 32; ++j) {
                sp[(2 * j) * 64] = s[j].x; sp[(2 * j + 1) * 64] = s[j].y;
                sp[(64 + 2 * j) * 64] = pp[j].x; sp[(64 + 2 * j + 1) * 64] = pp[j].y;
            }
        }
    }
}
__device__ __forceinline__ void rwkv_out(const Params& p, int l, int wave, int lane, LAS unsigned char* lds) {
    unsigned char* ws = p.ws; const int G = gridDim.x;
    const float* SIN = (const float*)(ws + WS_SIN); const float* YL = (const float*)(ws + WS_YL); const float* QQ = (const float*)(ws + WS_QQ);
    const bf16_t* BON = (const bf16_t*)(ws + WS_BON); const bf16_t* LR = (const bf16_t*)(ws + WS_LR); bf16_t* YCAT = (bf16_t*)(ws + WS_YCAT);
    LAS float* qb = (LAS float*)(lds + wave * 1024);
    for (int u2 = wave * G + bidx(); u2 < 3072; u2 += 8 * G) {
        const int u = u2 >> 2, qt = u2 & 3; const int c = u & 31, bh = u >> 5; const int b = bh / 12, h = bh - b * 12; const int ch = h * 64 + lane;
        const int m0 = b * SEQ + c * 128 + qt * 32;
        const float gnw = p.in[16][l * 768 + ch], gnb = p.in[17][l * 768 + ch];
        f32x2 s[32];
        { const float* sb_ = SIN + (size_t)u * 4096 + lane;
#pragma unroll
          for (int j = 0; j < 32; ++j) s[j] = (f32x2){sb_[(2 * j) * 64], sb_[(2 * j + 1) * 64]}; }
        float q4[4], y4[4], b4[4], g4[4];
#pragma unroll
        for (int q = 0; q < 4; ++q) { const size_t o = (size_t)(m0 + q) * 768; q4[q] = (QQ + o)[ch]; y4[q] = (YL + o)[ch]; b4[q] = BF2F((BON + o)[ch]); g4[q] = BF2F((LR + (size_t)(m0 + q) * 2304 + 1536)[ch]); }
        for (int bt = 0; bt < 8; ++bt) {
            float yc[4], bc[4], gc[4];
#pragma unroll
            for (int q = 0; q < 4; ++q) { qb[q * 64 + lane] = q4[q]; yc[q] = y4[q]; bc[q] = b4[q]; gc[q] = g4[q]; }
            if (bt + 1 < 8) {
#pragma unroll
                for (int q = 0; q < 4; ++q) { const size_t o = (size_t)(m0 + (bt + 1) * 4 + q) * 768; q4[q] = (QQ + o)[ch]; y4[q] = (YL + o)[ch]; b4[q] = BF2F((BON + o)[ch]); g4[q] = BF2F((LR + (size_t)(m0 + (bt + 1) * 4 + q) * 2304 + 1536)[ch]); }
            }
            WAVE_SYNC();
#pragma unroll
            for (int q = 0; q < 4; ++q) {
                const LAS f32x4* Q4 = (const LAS f32x4*)(qb + q * 64);
                f32x2 a0 = {0.f, 0.f}, a1 = {0.f, 0.f};
#pragma unroll
                for (int j = 0; j < 16; ++j) { const f32x4 v = Q4[j]; a0 += s[2 * j] * (f32x2){v.x, v.y}; a1 += s[2 * j + 1] * (f32x2){v.z, v.w}; }
                const float yo = yc[q] + (a0.x + a0.y) + (a1.x + a1.y);
                const float mean = wave_sum(yo) * (1.0f / 64.0f); const float d = yo - mean; const float var = wave_sum(d * d) * (1.0f / 64.0f);
                const float o = (d * rsqrtf(var + 64e-5f) * gnw + gnb + bc[q]) * gc[q];
                YCAT[(size_t)(m0 + bt * 4 + q) * DM + ch] = (bf16_t)(cvt_pk_bf16(o, 0.f) & 0xffffu);
            }
            WAVE_SYNC();
        }
    }
}
__device__ __forceinline__ void rwkv_combine(const Params& p, int bh, int wave, int lane, LAS unsigned char* lds) {
    LAS float* xs = (LAS float*)lds;
    LAS float* pw = (LAS float*)(lds + 16384 + wave * 2048);
    const float* SEND = (const float*)(p.ws + WS_SEND) + (size_t)bh * 32 * 8192 + (size_t)(wave * 8) * 64 + lane; float* SIN = (float*)(p.ws + WS_SIN) + (size_t)bh * 32 * 4096 + (size_t)(wave * 8) * 64 + lane;
    f32x2 s[32];
#pragma unroll
    for (int j = 0; j < 32; ++j) s[j] = (f32x2){0.f, 0.f};
    float own[8], pj[4][8], sl[4][8];
#pragma unroll
    for (int jj = 0; jj < 8; ++jj) own[jj] = 0.f;
#pragma unroll
    for (int d = 0; d < 4; ++d)
#pragma unroll
        for (int jj = 0; jj < 8; ++jj) { pj[d][jj] = SEND[(size_t)d * 8192 + (64 + jj) * 64]; sl[d][jj] = SEND[(size_t)d * 8192 + jj * 64]; }
    for (int c4 = 0; c4 < 8; ++c4) {
#pragma unroll
        for (int cc = 0; cc < 4; ++cc) {
            const int c = c4 * 4 + cc;
            float slc[8];
#pragma unroll
            for (int jj = 0; jj < 8; ++jj) { SIN[(size_t)c * 4096 + jj * 64] = own[jj]; pw[jj * 64 + lane] = pj[cc][jj]; slc[jj] = sl[cc][jj]; }
            if (c + 4 < 32) {
#pragma unroll
                for (int jj = 0; jj < 8; ++jj) { pj[cc][jj] = SEND[(size_t)(c + 4) * 8192 + (64 + jj) * 64]; sl[cc][jj] = SEND[(size_t)(c + 4) * 8192 + jj * 64]; }
            }
            WAVE_SYNC();
#pragma unroll
            for (int jj = 0; jj < 8; ++jj) {
                f32x2 a0 = {0.f, 0.f}, a1 = {0.f, 0.f};
#pragma unroll
                for (int i4 = 0; i4 < 16; ++i4) { const f32x4 pv = *(const LAS f32x4*)(pw + jj * 64 + i4 * 4); a0 += s[2 * i4] * (f32x2){pv.x, pv.y}; a1 += s[2 * i4 + 1] * (f32x2){pv.z, pv.w}; }
                own[jj] = slc[jj] + (a0.x + a0.y) + (a1.x + a1.y);
                xs[(wave * 8 + jj) * 64 + lane] = own[jj];
            }
            __syncthreads();
#pragma unroll
            for (int j = 0; j < 32; ++j) s[j] = (f32x2){xs[(2 * j) * 64 + lane], xs[(2 * j + 1) * 64 + lane]};
            __syncthreads();
        }
    }
}

constexpr int KP = 136, VP = 72;
constexpr int ATT_BUF = 64 * KP * 2 + 128 * VP * 2;
__device__ __forceinline__ void attn_phase(const Params& p, int l, int wave, int lane, LAS unsigned char* lds, int early) {
    const int tid = tidx(); unsigned char* ws = p.ws;
    const bf16_t* DAQK = (const bf16_t*)(ws + WS_DAQK); const bf16_t* VT = (const bf16_t*)(ws + WS_VT); bf16_t* YCAT = (bf16_t*)(ws + WS_YCAT);
    const float lam_init = 0.8f - 0.6f * expf(-0.3f * (float)l);
    const float d1 = wave_sum(p.in[18][l * 64 + lane] * p.in[19][l * 64 + lane]), d2 = wave_sum(p.in[20][l * 64 + lane] * p.in[21][l * 64 + lane]);
    const float lam = expf(d1) - expf(d2) + lam_init;
    const int sub = wave >> 2, rq = (wave & 3) * 32, qi = lane & 15, g4 = lane >> 4;
    const int x16 = (lane ^ 16) << 2, x32 = (lane ^ 32) << 2;
#define SHX(v, a) __builtin_bit_cast(float, __builtin_amdgcn_ds_bpermute((a), __builtin_bit_cast(int, (v))))
    unsigned* aq = (unsigned*)ws + 256 + l; unsigned* dn = (unsigned*)ws + 264 + l;
    volatile LAS int* ubox = (volatile LAS int*)(lds + 143360);
    for (;;) {
        __syncthreads();
        if (tid == 0) { int un = 384;
            if (!(early && __hip_atomic_load(dn, __ATOMIC_RELAXED, __HIP_MEMORY_SCOPE_AGENT) >= 24u)) un = (int)__hip_atomic_fetch_add(aq, 1u, __ATOMIC_RELAXED, __HIP_MEMORY_SCOPE_AGENT);
            *ubox = un; }
        __syncthreads();
        const int u = *ubox;
        if (u >= 384) break;
        const int qb = 31 - u / 12, rem = u % 12, b = rem / 6, h = rem % 6;
        const int q0 = qb * 128, kl = 2 * qb + 1;
        bf16x8 qf[2][2];
#pragma unroll
        for (int rt = 0; rt < 2; ++rt) { const bf16_t* qp = DAQK + (size_t)(b * SEQ + q0 + rq + 16 * rt + qi) * 1536 + h * 128 + sub * 64 + g4 * 8; qf[rt][0] = *(const bf16x8*)qp; qf[rt][1] = *(const bf16x8*)(qp + 32); }
        f32x4 o[2][8];
#pragma unroll
        for (int rt = 0; rt < 2; ++rt)
#pragma unroll
            for (int e = 0; e < 8; ++e) o[rt][e] = (f32x4){0.f, 0.f, 0.f, 0.f};
        float mrun[2] = {-1e30f, -1e30f}, lrun[2] = {0.f, 0.f};
        const int kr0 = tid >> 4, kc0 = tid & 15;
        const int vr0 = tid >> 3, vc0 = tid & 7;
        const bf16_t* kbase = DAQK + (size_t)(b * SEQ) * 1536 + 768 + h * 128 + kc0 * 8;
        const bf16_t* vbase = VT + (size_t)(b * 768 + h * 128) * SEQ + vc0 * 8;
        u32x4 kreg[2], vreg[2];
#define ATT_LOADR(KR, VR, kb) do { KR[0] = *(const u32x4*)(kbase + (size_t)((kb) * 64 + kr0) * 1536); KR[1] = *(const u32x4*)(kbase + (size_t)((kb) * 64 + kr0 + 32) * 1536); \
        VR[0] = *(const u32x4*)(vbase + (size_t)vr0 * SEQ + (kb) * 64); VR[1] = *(const u32x4*)(vbase + (size_t)(vr0 + 64) * SEQ + (kb) * 64); } while (0)
#define ATT_STORER(KR, VR, buf) do { LAS unsigned char* kb_ = lds + (buf) * ATT_BUF; LAS unsigned char* vb_ = kb_ + 64 * KP * 2; \
        *(LAS u32x4*)(kb_ + (kr0 * KP + kc0 * 8) * 2) = KR[0]; *(LAS u32x4*)(kb_ + ((kr0 + 32) * KP + kc0 * 8) * 2) = KR[1]; \
        *(LAS u32x4*)(vb_ + (vr0 * VP + vc0 * 8) * 2) = VR[0]; *(LAS u32x4*)(vb_ + ((vr0 + 64) * VP + vc0 * 8) * 2) = VR[1]; } while (0)
#define ATT_COMPUTE(kb) do { \
            const LAS unsigned char* kt = lds + ((kb) & 1) * ATT_BUF; const LAS unsigned char* vt = kt + 64 * KP * 2; \
            f32x4 st[2][4]; \
            __builtin_amdgcn_s_setprio(1); \
            _Pragma("unroll") for (int mt = 0; mt < 4; ++mt) { \
                st[0][mt] = (f32x4){0.f, 0.f, 0.f, 0.f}; st[1][mt] = (f32x4){0.f, 0.f, 0.f, 0.f}; \
                _Pragma("unroll") for (int ks = 0; ks < 2; ++ks) { \
                    const bf16x8 ka = *(const LAS bf16x8*)(kt + ((16 * mt + qi) * KP + sub * 64 + ks * 32 + g4 * 8) * 2); \
                    st[0][mt] = __builtin_amdgcn_mfma_f32_16x16x32_bf16(ka, qf[0][ks], st[0][mt], 0, 0, 0); \
                    st[1][mt] = __builtin_amdgcn_mfma_f32_16x16x32_bf16(ka, qf[1][ks], st[1][mt], 0, 0, 0); \
                } \
            } \
            __builtin_amdgcn_s_setprio(0); \
            bf16x8 pb[2][2]; \
            _Pragma("unroll") for (int rt = 0; rt < 2; ++rt) { \
                const int qrel = q0 + rq + 16 * rt - (kb) * 64;            \
                if (qrel < 63) { \
                    _Pragma("unroll") for (int mt = 0; mt < 4; ++mt) \
                        _Pragma("unroll") for (int i = 0; i < 4; ++i) if (16 * mt + 4 * g4 + i > qrel + qi) st[rt][mt][i] = -1e30f; \
                } \
                float mx = st[rt][0][0]; \
                _Pragma("unroll") for (int mt = 0; mt < 4; ++mt) \
                    _Pragma("unroll") for (int i = 0; i < 4; ++i) mx = fmaxf(mx, st[rt][mt][i]); \
                mx = fmaxf(mx, SHX(mx, x16)); mx = fmaxf(mx, SHX(mx, x32)); \
                const float mnew = fmaxf(mrun[rt], mx); const float alpha = __builtin_amdgcn_exp2f(mrun[rt] - mnew); mrun[rt] = mnew; \
                float ps = 0.f; \
                _Pragma("unroll") for (int mt = 0; mt < 4; ++mt) \
                    _Pragma("unroll") for (int i = 0; i < 4; ++i) { const float e = __builtin_amdgcn_exp2f(st[rt][mt][i] - mnew); st[rt][mt][i] = e; ps += e; } \
                lrun[rt] = lrun[rt] * alpha + ps; \
                if (__builtin_amdgcn_ballot_w64(alpha != 1.0f) != 0ull) { _Pragma("unroll") for (int e = 0; e < 8; ++e) o[rt][e] = o[rt][e] * alpha; } \
                _Pragma("unroll") for (int jp = 0; jp < 2; ++jp) { \
                    u32x4 pw4; pw4.x = cvt_pk_bf16(st[rt][2 * jp][0], st[rt][2 * jp][1]); pw4.y = cvt_pk_bf16(st[rt][2 * jp][2], st[rt][2 * jp][3]); \
                    pw4.z = cvt_pk_bf16(st[rt][2 * jp + 1][0], st[rt][2 * jp + 1][1]); pw4.w = cvt_pk_bf16(st[rt][2 * jp + 1][2], st[rt][2 * jp + 1][3]); \
                    pb[rt][jp] = __builtin_bit_cast(bf16x8, pw4); } \
            } \
            __builtin_amdgcn_s_setprio(1); \
            _Pragma("unroll") for (int jp = 0; jp < 2; ++jp) \
                _Pragma("unroll") for (int e = 0; e < 8; ++e) { \
                    const LAS unsigned char* vp = vt + ((16 * e + qi) * VP + 32 * jp + 4 * g4) * 2; \
                    const u32x2 lo = *(const LAS u32x2*)vp, hi = *(const LAS u32x2*)(vp + 32); \
                    u32x4 va4; va4.x = lo.x; va4.y = lo.y; va4.z = hi.x; va4.w = hi.y; const bf16x8 va = __builtin_bit_cast(bf16x8, va4); \
                    o[0][e] = __builtin_amdgcn_mfma_f32_16x16x32_bf16(va, pb[0][jp], o[0][e], 0, 0, 0); \
                    o[1][e] = __builtin_amdgcn_mfma_f32_16x16x32_bf16(va, pb[1][jp], o[1][e], 0, 0, 0); \
                } \
            __builtin_amdgcn_s_setprio(0); \
        } while (0)
        __syncthreads();
        ATT_LOADR(kreg, vreg, 0); ATT_STORER(kreg, vreg, 0);
        __syncthreads();
        for (int kb = 0; kb <= kl; ++kb) {
            if (kb < kl) ATT_LOADR(kreg, vreg, kb + 1);
            ATT_COMPUTE(kb);
            if (kb < kl) ATT_STORER(kreg, vreg, (kb + 1) & 1);
            __syncthreads();
        }
#undef ATT_LOADR
#undef ATT_STORER
#undef ATT_COMPUTE
        float inv[2];
#pragma unroll
        for (int rt = 0; rt < 2; ++rt) { float lt = lrun[rt]; lt += SHX(lt, x16); lt += SHX(lt, x32); inv[rt] = 1.0f / lt; }
        if (sub == 1) {
#pragma unroll
            for (int rt = 0; rt < 2; ++rt) { LAS float* ox = (LAS float*)lds + ((wave & 3) * 2 + rt) * 2048;
#pragma unroll
                for (int e = 0; e < 8; ++e)
#pragma unroll
                    for (int i = 0; i < 4; ++i) ox[(16 * e + 4 * g4 + i) * 16 + qi] = o[rt][e][i] * inv[rt]; }
        }
        __syncthreads();
        if (sub == 0) {
#pragma unroll
            for (int rt = 0; rt < 2; ++rt) {
                const LAS float* ox = (const LAS float*)lds + ((wave & 3) * 2 + rt) * 2048;
                float ssq = 0.f;
#pragma unroll
                for (int e = 0; e < 8; ++e)
#pragma unroll
                    for (int i = 0; i < 4; ++i) { const float v = o[rt][e][i] * inv[rt] - lam * ox[(16 * e + 4 * g4 + i) * 16 + qi]; o[rt][e][i] = v; ssq += v * v; }
                ssq += SHX(ssq, x16); ssq += SHX(ssq, x32);
                const float rn = rsqrtf(ssq * (1.0f / 128.0f) + 1e-5f) * (1.0f - lam_init);
                bf16_t* yp = YCAT + (size_t)(b * SEQ + q0 + rq + 16 * rt + qi) * DM + 768 + h * 128;
#pragma unroll
                for (int e = 0; e < 8; ++e) {
                    const f32x4 sw = *(const f32x4*)(p.in[22] + l * 128 + 16 * e + 4 * g4);
                    u32x2 w; w.x = cvt_pk_bf16(o[rt][e][0] * rn * sw.x, o[rt][e][1] * rn * sw.y); w.y = cvt_pk_bf16(o[rt][e][2] * rn * sw.z, o[rt][e][3] * rn * sw.w);
                    *(u32x2*)(yp + 16 * e + 4 * g4) = w;
                }
            }
        }
    }
}
template <class Epi>
__device__ __forceinline__ void run_gemm(LAS unsigned char* lds, const bf16_t* A, const bf16_t* Bt, int N, int K, const Epi& E) {
    pg8::Gemm g; g.A = A; g.Bt = Bt; g.M = MT; g.N = N; g.K = K;
    pg8::StaticOrder S; S.init(MT, N, gridDim.x, bidx());
    pg8::gemm_phase<Epi, pg8::StaticOrder, true, true>(lds, g, S, E);
}

#ifndef PHASE_MASK
#define PHASE_MASK 0xFFFFu
#endif
constexpr unsigned PHM = PHASE_MASK;
#ifndef DUP_MASK
#define DUP_MASK 0
#endif
constexpr unsigned DUPM = DUP_MASK;
#define PON(k) ((PHM >> (k)) & 1u)
__global__ void __launch_bounds__(512, 2) mk_fwd(Params p) {
    extern __shared__ __attribute__((aligned(16))) unsigned char smem[];
    LAS unsigned char* lds = (LAS unsigned char*)smem;
    cg::grid_group grid = cg::this_grid();
    volatile LAS unsigned* xst = (volatile LAS unsigned*)(lds + 143368);
    if (threadIdx.x == 0) { xst[0] = 0u; xst[1] = 0u;
        __hip_atomic_fetch_add((unsigned*)p.ws + 1536 + ((unsigned)__builtin_amdgcn_s_getreg((3 << 11) | 20) & 0xFu), 1u, __ATOMIC_RELAXED, __HIP_MEMORY_SCOPE_AGENT); }
    __syncthreads();
    unsigned char* ws = p.ws;
    bf16_t* XB = (bf16_t*)(ws + WS_XB); float* RS = (float*)(ws + WS_RS); bf16_t* YCAT = (bf16_t*)(ws + WS_YCAT);
    bf16_t* ACT = (bf16_t*)(ws + WS_ACT); bf16_t* H = (bf16_t*)(ws + WS_H);
    for (int ph = p.ph_lo; ph < p.ph_hi; ++ph) {
        const int s_ = (ph == 0) ? -1 : (ph - 1) % NPL;
        int nrep = 1;
        if (DUPM) { const int kind = (ph == 0) ? 0 : ((s_ == 0 || s_ == 13) ? 1 : ((s_ == 1 || s_ == 14 || s_ == 11 || s_ == 5) ? 2 : ((s_ == 2 || s_ == 12 || s_ == 15) ? 3 : ((s_ == 3) ? 4 : (s_ - 4 + 5)))));
            if ((DUPM >> kind) & 1u) nrep = 2; }
        for (int rep = 0; rep < nrep; ++rep) {
        if (rep) grid.sync();
        const int tid = tidx(), lane = tid & 63, wave = __builtin_amdgcn_readfirstlane(tid >> 6);
        if (ph == 0) { if (PON(0)) prologue(p, lds, wave, lane); }
        else {
            const int l = (ph - 1) / NPL, s = (ph - 1) % NPL;
            if ((s == 0 || s == 13) && PON(1)) {
                EpiGU E; E.ACT = ACT; E.rs = RS;
                run_gemm(lds, XB, (const bf16_t*)(ws + WS_WGU + (size_t)(l * 2 + (s == 13)) * SZ_WGU), 2 * FF, DM, E);
            } else if ((s == 1 || s == 14 || s == 11 || s == 5) && PON(2)) {
                EpiBF E; E.C = (s == 5) ? (bf16_t*)(ws + WS_LR) : H; E.ldc = (s == 5) ? 2304 : DM;
                const bf16_t* Ag = (s == 11) ? YCAT : ((s == 5) ? (const bf16_t*)(ws + WS_LA) : ACT);
                const bf16_t* Bg = (s == 11) ? (const bf16_t*)(ws + WS_WOUT + (size_t)l * SZ_WOUT) : ((s == 5) ? (const bf16_t*)(ws + WS_WLORA + (size_t)l * SZ_WLORA) : (const bf16_t*)(ws + WS_WD + (size_t)(l * 2 + (s == 14)) * SZ_WD));
                run_gemm(lds, Ag, Bg, (s == 5) ? 2304 : DM, (s == 11) ? DM : ((s == 5) ? 256 : FF), E);
                if (s != 5 && gridDim.x == 256) {
                    pg8::StaticOrder S; S.init(MT, DM, 256, bidx()); Unit un; S.next(0, un);
                    const int wh = (s == 1) ? 0 : ((s == 11) ? 1 : 2);
                    unsigned* cnt = (unsigned*)ws + (l * 3 + wh) * 32 + un.pm;
                    __syncthreads();
                    if (tidx() == 0) { __threadfence(); __hip_atomic_fetch_add(cnt, 1u, __ATOMIC_RELAXED, __HIP_MEMORY_SCOPE_AGENT);
                        while (__hip_atomic_load(cnt, __ATOMIC_RELAXED, __HIP_MEMORY_SCOPE_AGENT) < 8u) __builtin_amdgcn_s_sleep(2);
                        __threadfence(); }
                    __syncthreads();
                    const int tid2 = tidx(), lane2 = tid2 & 63, wave2 = __builtin_amdgcn_readfirstlane(tid2 >> 6);
                    const float* g = p.in[s == 1 ? 4 : (s == 11 ? 34 : 38)] + l * DM;
                    row_phase(H, nullptr, (ph == NPH - 2) ? p.out : nullptr, XB, RS, g, s == 11 ? 1.0f : 0.5f, wave2, lane2, un.pm * 256 + un.pn * 32, 32);
                }
            } else if ((s == 2 || s == 12 || s == 15) && PON(3) && gridDim.x != 256) {
                const float* g = p.in[s == 2 ? 4 : (s == 12 ? 34 : 38)] + l * DM;
                row_phase(H, nullptr, (ph == NPH - 1) ? p.out : nullptr, XB, RS, g, s == 12 ? 1.0f : 0.5f, wave, lane);
            } else if (s == 3 && PON(4)) {
                EpiIN E; E.ZR = (float*)(ws + WS_ZR); E.DAQK = (bf16_t*)(ws + WS_DAQK); E.VT = (bf16_t*)(ws + WS_VT); E.ZS = (float*)(ws + WS_ZS); E.rs = RS;
                run_gemm(lds, XB, (const bf16_t*)(ws + WS_WIN + (size_t)l * SZ_WIN), INC, DM, E);
            } else if (s == 4 && PON(5)) {
                la_prep(p, l);
                s5_scan<1>(p, l, wave - 4, 4, bidx(), gridDim.x, lane, lds);
            } else if (s == 6 && PON(7)) {
                rwkv_scan<1>(p, l, wave, lane, lds);
                s5_scan<2>(p, l, (wave == 3) ? 0 : ((wave == 7) ? 1 : -1), 2, bidx(), gridDim.x, lane, lds + 24576);
            } else if ((s == 7 || s == 9) && PON(8)) {
                const int tid_ = tidx(), lane = tid_ & 63, wave = __builtin_amdgcn_readfirstlane(tid_ >> 6);
                const int G = gridDim.x; bool do_attn = true;
                if (s == 7) {
                    if (G >= 48) {
                        if (bidx() < 24) { rwkv_combine(p, bidx(), wave, lane, lds);
                            __syncthreads(); if (tidx() == 0) __hip_atomic_fetch_add((unsigned*)ws + 264 + l, 1u, __ATOMIC_RELAXED, __HIP_MEMORY_SCOPE_AGENT);
                            do_attn = false; }
                        else if (l == 0) { for (int gt = 2536 + bidx() - 24; gt < 2536 + 1376; gt += G - 24) weight_tile(p, gt, lds); }
                    } else {
                        for (int bh = bidx(); bh < 24; bh += G) rwkv_combine(p, bh, wave, lane, lds);
                        if (l == 0) { __syncthreads(); for (int gt = 2536 + bidx(); gt < 2536 + 1376; gt += G) weight_tile(p, gt, lds); }
                        do_attn = false;
                    }
                } else {
                    EpiGLU E; E.YCAT = YCAT; E.YS = (const float*)(ws + WS_YS); E.bglu = p.in[32] + l * 512;
                    run_gemm(lds, (const bf16_t*)(ws + WS_YSB), (const bf16_t*)(ws + WS_WGLU + (size_t)l * SZ_WGLU), 512, 512, E);
                }
                if (do_attn && PON(11)) attn_phase(p, l, wave, lane, lds, s == 7);
            } else if (s == 8 && PON(9)) {
                rwkv_out(p, l, wave, lane, lds);
            }
        }
        }
        { const int sx = (ph > 0) ? (ph - 1) % NPL : -1; const bool skip = (sx == 10) || (gridDim.x == 256 && (sx == 2 || sx == 12 || sx == 15));
          if (ph + 1 < p.ph_hi && !skip) {
              if (ph == p.ph_lo) grid.sync();
              else {
                  asm volatile("s_waitcnt vmcnt(0)" ::: "memory");
                  __syncthreads();
                  if (threadIdx.x == 0) {
                      unsigned* wsw = (unsigned*)p.ws; unsigned* base = wsw + 16384 + ph * 4096;
                      const unsigned xcc = (unsigned)__builtin_amdgcn_s_getreg((3 << 11) | 20) & 0xFu;
                      unsigned nloc = xst[0], nx = xst[1];
                      if (nloc == 0u) {
                          nx = 0u;
#pragma unroll
                          for (unsigned j = 0; j < 16; ++j) { const unsigned cj = __hip_atomic_load(wsw + 1536 + j, __ATOMIC_RELAXED, __HIP_MEMORY_SCOPE_AGENT); nx += (cj > 0u) ? 1u : 0u; nloc = (j == xcc) ? cj : nloc; }
                          xst[0] = nloc; xst[1] = nx;
                      }
                      const unsigned old = __hip_atomic_fetch_add(base + xcc * 64, 1u, __ATOMIC_RELAXED, __HIP_MEMORY_SCOPE_AGENT);
                      if (old + 1u == nloc) {
                          __builtin_amdgcn_fence(__ATOMIC_RELEASE, "agent");
                          asm volatile("s_waitcnt vmcnt(0)" ::: "memory");
                          const unsigned ot = __hip_atomic_fetch_add(base + 2048, 1u, __ATOMIC_RELAXED, __HIP_MEMORY_SCOPE_AGENT);
                          if (ot + 1u != nx) while (__hip_atomic_load(base + 2048, __ATOMIC_RELAXED, __HIP_MEMORY_SCOPE_AGENT) < nx) __builtin_amdgcn_s_sleep(1);
                          __builtin_amdgcn_fence(__ATOMIC_ACQUIRE, "agent");
                          __hip_atomic_fetch_add(base + 1024 + xcc * 64, 1u, __ATOMIC_RELAXED, __HIP_MEMORY_SCOPE_AGENT);
                          asm volatile("s_waitcnt vmcnt(0)" ::: "memory");
                      } else {
                          while (__hip_atomic_load(base + 1024 + xcc * 64, __ATOMIC_RELAXED, __HIP_MEMORY_SCOPE_AGENT) == 0u) __builtin_amdgcn_s_sleep(1);
                          __builtin_amdgcn_fence(__ATOMIC_ACQUIRE, "agent");
                          asm volatile("s_waitcnt vmcnt(0)" ::: "memory");
                      }
                  }
                  __syncthreads();
              }
          } }
    }
}

extern "C" void kernel_launch(void* const* d_in, const int* in_sizes, int n_in, void* d_out, int out_size, void* d_ws, size_t ws_size, hipStream_t stream) {
    static int grid = 0;
    if (grid == 0) {
        if (n_in != 39 || out_size != MT * DM || ws_size < WS_END) { fprintf(stderr, "kernel_launch: unexpected sizes: n_in %d out %d ws %zu (need %zu)\n", n_in, out_size, ws_size, (size_t)WS_END); grid = -1; return; }
        int dev = 0, cus = 0, per_cu = 0;
        hipGetDevice(&dev); hipDeviceGetAttribute(&cus, hipDeviceAttributeMultiprocessorCount, dev);
        if (hipFuncSetAttribute((const void*)mk_fwd, hipFuncAttributeMaxDynamicSharedMemorySize, LDS_BYTES) != hipSuccess) { fprintf(stderr, "kernel_launch: hipFuncSetAttribute failed\n"); grid = -1; return; }
        if (hipOccupancyMaxActiveBlocksPerMultiprocessor(&per_cu, (const void*)mk_fwd, 512, LDS_BYTES) != hipSuccess || per_cu < 1) { fprintf(stderr, "kernel_launch: occupancy query gives %d\n", per_cu); per_cu = 1; }
        (void)hipGetLastError();
        grid = cus * 1;
        fprintf(stderr, "kernel_launch: cus %d per_cu %d grid %d\n", cus, per_cu, grid);
    }
    if (grid < 0) return;
    if (hipMemsetAsync(d_ws, 0, 1u << 20, stream) != hipSuccess) { fprintf(stderr, "kernel_launch: hipMemsetAsync failed\n"); return; }
    Params a{};
    for (int i = 0; i < 39; ++i) a.in[i] = (const float*)d_in[i];
    a.out = (float*)d_out; a.ws = (unsigned char*)d_ws;
#if ONE_LAUNCH
    a.ph_lo = 0; a.ph_hi = NPH;
    void* args[] = {&a};
    hipError_t e = hipLaunchCooperativeKernel((const void*)mk_fwd, dim3(grid), dim3(512), args, LDS_BYTES, stream);
    if (e != hipSuccess) fprintf(stderr, "cooperative launch failed: %s (grid %d)\n", hipGetErrorString(e), grid);
#else
    for (int ph = 0; ph < NPH; ++ph) {
        a.ph_lo = ph; a.ph_hi = ph + 1;
        hipLaunchKernelGGL(mk_fwd, dim3(grid), dim3(512), LDS_BYTES, stream, a);
    }
#endif
}
```

```cpp
#include <hip/hip_runtime.h>
#include <hip/hip_cooperative_groups.h>
#include <cstdio>
#include <cstdint>
namespace cg = cooperative_groups;
#ifndef ONE_LAUNCH
#define ONE_LAUNCH 1
#endif
__device__ __forceinline__ int tidx() { int t = threadIdx.x; asm volatile("" : "+v"(t)); return t; }
__device__ __forceinline__ int bidx() { int b = blockIdx.x; asm volatile("" : "+s"(b)); return b; }
namespace pg8 {
#define PG8_LAS __attribute__((address_space(3)))
typedef unsigned short bf16_t;
typedef short bf16x8 __attribute__((ext_vector_type(8)));
typedef float f32x4 __attribute__((ext_vector_type(4)));
typedef unsigned u32x4 __attribute__((ext_vector_type(4)));
constexpr int BM = 256, BK = 64, HALF = 128, HTB = HALF * BK * 2  , STAGE_BYTES = 8 * HTB, NXCD = 8, WGM = 8;

__host__ __device__ __forceinline__ int lds_byte(int r, int c) { const int st = (r >> 4) * 2 + (c >> 5), rr = r & 15, cc = c & 31, ob = rr * 64 + cc * 2; return st * 1024 + (ob ^ (((ob >> 9) & 1) << 5)); }
__host__ __device__ __forceinline__ void stage_rc(int b, int& R, int& C) { const int st = b / 1024, sb = b % 1024, swz = sb ^ (((sb >> 9) & 1) << 5); R = (st >> 1) * 16 + swz / 64; C = (st & 1) * 32 + (swz % 64) / 2; }
__host__ __device__ __forceinline__ int perm32(int rho) { const int n = rho >> 4, i = rho & 15; return 8 * (i >> 2) + 4 * n + (i & 3); }

struct Unit { int pm, pn; };
struct Gemm { const bf16_t* A; const bf16_t* Bt; int M, N, K; };

struct StaticOrder {
    int nM, nN, nwg, G, c;
    __host__ __device__ void init(int M, int N, int G_, int c_) { nM = M / BM; nN = N / BM; nwg = nM * nN; G = G_; c = c_; }
    __host__ __device__ bool next(int i, Unit& u) const {
        const long L = (long)i * G + c; if (L >= nwg) return false;
        int wgid = (int)L; { const int q = nwg / NXCD, r = nwg % NXCD, xcd = wgid % NXCD, off = wgid / NXCD; wgid = (xcd < r ? xcd * (q + 1) : r * (q + 1) + (xcd - r) * q) + off; }
        const int wgm = (nN == 8) ? 4 : WGM;
        const int nig = wgm * nN, gid = wgid / nig, fm = gid * wgm, gsz = (nM - fm) < wgm ? (nM - fm) : wgm;
        u.pm = fm + ((wgid % nig) % gsz); u.pn = (wgid % nig) / gsz; return true;
    }
    __device__ __forceinline__ void a_ready(const Unit&) const {}
    __device__ __forceinline__ void done(const Unit&) const {}
};

__device__ __forceinline__ unsigned cvt_pk_bf16(float lo, float hi) { unsigned r; asm volatile("v_cvt_pk_bf16_f32 %0, %1, %2" : "=v"(r) : "v"(lo), "v"(hi)); return r; }
typedef float f32x2 __attribute__((ext_vector_type(2)));

template <class Epi, class Sched, bool ALIGN_EPI = false, bool SP2 = false>
__device__ __forceinline__ void gemm_phase(PG8_LAS unsigned char* lds, const Gemm g, const Sched& S, const Epi& E) {
    const int tid = tidx(), wid = __builtin_amdgcn_readfirstlane(tid >> 6), lane = tid & 63, wr = wid >> 2, wc = wid & 3, fr = lane & 15, fq = lane >> 4;
    const int K = g.K, nt = K / BK;
    unsigned voffA[2], voffB[2];
#pragma unroll
    for (int i = 0; i < 2; ++i) { int R, C; stage_rc(tid * 16 + i * 8192, R, C); const int Rb = Epi::PERM ? ((R & ~31) + perm32(R & 31)) : R;
        voffA[i] = (unsigned)(R * K + C) * 2u; voffB[i] = (unsigned)(Rb * K + C) * 2u; }
    const size_t kstep = (size_t)(BK * 2);
    const size_t hstep = (size_t)HALF * K * 2;
    const size_t tstep = 2 * hstep;
    const unsigned ldsw = (unsigned)wid * 1024u;
    const int aoff = lds_byte(wr * 64 + fr, fq * 8), boff = lds_byte(wc * 32 + fr, fq * 8);
#define PG8_SA(b, h) (((b) * 2 + (h)) * HTB)
#define PG8_SB(b, h) ((4 + (b) * 2 + (h)) * HTB)
#define PG8_STAGE(bufoff, gbase, voff) do { _Pragma("unroll") for (int _i = 0; _i < 2; ++_i) \
        __builtin_amdgcn_global_load_lds((const unsigned*)((const char*)(gbase) + (voff)[_i]), (PG8_LAS unsigned*)(lds + (bufoff) + ldsw + _i * 8192), 16, 0, 0); } while (0)
#define PG8_LDA(dst, b, h) do { _Pragma("unroll") for (int m = 0; m < 4; ++m) _Pragma("unroll") for (int k = 0; k < 2; ++k) dst[m][k] = *(const PG8_LAS bf16x8*)(lds + PG8_SA(b, h) + aoff + m * 2048 + k * 1024); } while (0)
#define PG8_LDB(dst, b, h) do { _Pragma("unroll") for (int n = 0; n < 2; ++n) _Pragma("unroll") for (int k = 0; k < 2; ++k) dst[n][k] = *(const PG8_LAS bf16x8*)(lds + PG8_SB(b, h) + boff + n * 2048 + k * 1024); } while (0)
#define PG8_MMA(ai, bj, At, Bt) do { __builtin_amdgcn_s_setprio(1); _Pragma("unroll") for (int m = 0; m < 4; ++m) _Pragma("unroll") for (int n = 0; n < 2; ++n) _Pragma("unroll") for (int k = 0; k < 2; ++k) \
        acc[ai][bj][m][n] = __builtin_amdgcn_mfma_f32_16x16x32_bf16(Bt[n][k], At[m][k], acc[ai][bj][m][n], 0, 0, 0); __builtin_amdgcn_s_setprio(0); } while (0)
#define PG8_WAIT_V(n) asm volatile("s_waitcnt vmcnt(" #n ")" ::: "memory")
#define PG8_WAIT_L(n) asm volatile("s_waitcnt lgkmcnt(" #n ")" ::: "memory")
#define PG8_BAR __builtin_amdgcn_s_barrier()
#define PG8_SCHED __builtin_amdgcn_sched_barrier(0)
    Unit cur, nxt; int ui = 0;
    if (!S.next(0, cur)) return;
    f32x4 acc[2][2][4][2];
#pragma unroll
    for (int a = 0; a < 2; ++a)
#pragma unroll
        for (int b = 0; b < 2; ++b)
#pragma unroll
            for (int m = 0; m < 4; ++m)
#pragma unroll
                for (int n = 0; n < 2; ++n) acc[a][b][m][n] = (f32x4){0.f, 0.f, 0.f, 0.f};
    bf16x8 At[4][2], B0[2][2], B1[2][2];
    const char* cA = (const char*)g.A + (size_t)cur.pm * tstep; const char* cB = (const char*)g.Bt + (size_t)cur.pn * tstep;
    S.a_ready(cur);
    if constexpr (SP2) {
        PG8_STAGE(PG8_SB(0, 0), cB, voffB); PG8_STAGE(PG8_SB(0, 1), cB + hstep, voffB); PG8_STAGE(PG8_SA(0, 0), cA, voffA); PG8_STAGE(PG8_SA(0, 1), cA + hstep, voffA);
        if (wr == 1) PG8_BAR;
        PG8_WAIT_V(2); PG8_BAR;
        PG8_STAGE(PG8_SB(1, 0), cB + kstep, voffB); PG8_STAGE(PG8_SA(1, 0), cA + kstep, voffA); PG8_STAGE(PG8_SB(1, 1), cB + hstep + kstep, voffB);
        PG8_WAIT_V(6); PG8_BAR;
    } else {
        PG8_STAGE(PG8_SB(0, 0), cB, voffB); PG8_STAGE(PG8_SA(0, 0), cA, voffA); PG8_STAGE(PG8_SB(0, 1), cB + hstep, voffB); PG8_STAGE(PG8_SA(0, 1), cA + hstep, voffA);
        if (wr == 1) PG8_BAR;
        PG8_WAIT_V(4); PG8_BAR;
        PG8_STAGE(PG8_SB(1, 0), cB + kstep, voffB); PG8_STAGE(PG8_SA(1, 0), cA + kstep, voffA); PG8_STAGE(PG8_SB(1, 1), cB + hstep + kstep, voffB);
        PG8_WAIT_V(6); PG8_BAR;
    }
    for (;;) {
        const bool has_next = S.next(ui + 1, nxt);
        const char* nA = has_next ? (const char*)g.A + (size_t)nxt.pm * tstep : cA; const char* nB = has_next ? (const char*)g.Bt + (size_t)nxt.pn * tstep : cB;
        for (int t = 0; t < nt; t += 2) {
            const bool last = (t == nt - 2);
            const char* a1 = cA + (size_t)(t + 1) * kstep;
            const char* a2 = last ? nA : cA + (size_t)(t + 2) * kstep; const char* b2 = last ? nB : cB + (size_t)(t + 2) * kstep;
            const char* a3 = a2 + kstep; const char* b3 = b2 + kstep;
            if (last && has_next) S.a_ready(nxt);
            if constexpr (SP2) {
            PG8_LDB(B0, 0, 0); PG8_LDB(B1, 0, 1); PG8_SCHED; PG8_LDA(At, 0, 0); PG8_STAGE(PG8_SA(1, 1), a1 + hstep, voffA);
            PG8_WAIT_V(8); PG8_WAIT_L(0); PG8_BAR; PG8_MMA(0, 0, At, B0); PG8_MMA(0, 1, At, B1); PG8_BAR; PG8_SCHED;
            PG8_LDA(At, 0, 1); PG8_STAGE(PG8_SB(0, 0), b2, voffB); PG8_STAGE(PG8_SB(0, 1), b2 + hstep, voffB); PG8_STAGE(PG8_SA(0, 0), a2, voffA);
            PG8_WAIT_V(8); PG8_WAIT_L(0); PG8_BAR; PG8_MMA(1, 0, At, B0); PG8_MMA(1, 1, At, B1); PG8_BAR; PG8_SCHED;
            PG8_LDB(B0, 1, 0); PG8_LDB(B1, 1, 1); PG8_SCHED; PG8_LDA(At, 1, 0); PG8_STAGE(PG8_SA(0, 1), a2 + hstep, voffA);
            PG8_WAIT_V(8); PG8_WAIT_L(0); PG8_BAR; PG8_MMA(0, 0, At, B0); PG8_MMA(0, 1, At, B1); PG8_BAR; PG8_SCHED;
            PG8_LDA(At, 1, 1); PG8_STAGE(PG8_SB(1, 0), b3, voffB); PG8_STAGE(PG8_SB(1, 1), b3 + hstep, voffB); PG8_STAGE(PG8_SA(1, 0), a3, voffA);
            PG8_WAIT_V(8); PG8_WAIT_L(0); PG8_BAR; PG8_MMA(1, 0, At, B0); PG8_MMA(1, 1, At, B1); PG8_BAR; PG8_SCHED;
            } else {
            PG8_LDB(B0, 0, 0); PG8_SCHED; PG8_LDA(At, 0, 0); PG8_STAGE(PG8_SA(1, 1), a1 + hstep, voffA);
            PG8_WAIT_L(8); PG8_BAR; PG8_WAIT_L(0); PG8_MMA(0, 0, At, B0); PG8_BAR; PG8_SCHED;
            PG8_LDB(B1, 0, 1); PG8_STAGE(PG8_SB(0, 0), b2, voffB);
            PG8_BAR; PG8_WAIT_L(0); PG8_MMA(0, 1, At, B1); PG8_BAR;
            PG8_LDA(At, 0, 1); PG8_STAGE(PG8_SA(0, 0), a2, voffA);
            PG8_BAR; PG8_WAIT_L(0); PG8_MMA(1, 0, At, B0); PG8_BAR; PG8_SCHED;
            PG8_STAGE(PG8_SB(0, 1), b2 + hstep, voffB);
            PG8_WAIT_V(6); PG8_BAR; PG8_MMA(1, 1, At, B1); PG8_BAR;
            PG8_LDB(B0, 1, 0); PG8_SCHED; PG8_LDA(At, 1, 0); PG8_STAGE(PG8_SA(0, 1), a2 + hstep, voffA);
            PG8_WAIT_L(8); PG8_BAR; PG8_WAIT_L(0); PG8_MMA(0, 0, At, B0); PG8_BAR; PG8_SCHED;
            PG8_LDB(B1, 1, 1); PG8_STAGE(PG8_SB(1, 0), b3, voffB);
            PG8_BAR; PG8_WAIT_L(0); PG8_MMA(0, 1, At, B1); PG8_BAR;
            PG8_LDA(At, 1, 1); PG8_STAGE(PG8_SA(1, 0), a3, voffA);
            PG8_BAR; PG8_WAIT_L(0); PG8_MMA(1, 0, At, B0); PG8_BAR; PG8_SCHED;
            PG8_STAGE(PG8_SB(1, 1), b3 + hstep, voffB);
            PG8_WAIT_V(6); PG8_BAR; PG8_MMA(1, 1, At, B1); PG8_BAR;
            }
        }
        if constexpr (ALIGN_EPI) { if (wr == 0) PG8_BAR; }
        if constexpr (!Epi::AFTER_DRAIN) { E(acc, cur, wr, wc, fr, fq); S.done(cur); }
        if (!has_next) break;
#pragma unroll
        for (int a = 0; a < 2; ++a)
#pragma unroll
            for (int b = 0; b < 2; ++b)
#pragma unroll
                for (int m = 0; m < 4; ++m)
#pragma unroll
                    for (int n = 0; n < 2; ++n) acc[a][b][m][n] = (f32x4){0.f, 0.f, 0.f, 0.f};
        cur = nxt; cA = nA; cB = nB; ++ui;
        if constexpr (ALIGN_EPI) { if (wr == 1) PG8_BAR; }
    }
    PG8_WAIT_V(0);
    if constexpr (!ALIGN_EPI) { if (wr == 0) PG8_BAR; }
    PG8_BAR;
    if constexpr (Epi::AFTER_DRAIN) { E.fused(acc, cur, wr, wc, fr, fq, lds, wid, lane); S.done(cur); }
#undef PG8_SA
#undef PG8_SB
#undef PG8_STAGE
#undef PG8_LDA
#undef PG8_LDB
#undef PG8_MMA
#undef PG8_WAIT_V
#undef PG8_WAIT_L
#undef PG8_BAR
#undef PG8_SCHED
}
}
using pg8::bf16_t; using pg8::bf16x8; using pg8::f32x4; using pg8::u32x4; using pg8::Unit; using pg8::cvt_pk_bf16;
#define LAS __attribute__((address_space(3)))
typedef float f32x2 __attribute__((ext_vector_type(2)));
typedef unsigned u32x2 __attribute__((ext_vector_type(2)));
typedef short bf16x4 __attribute__((ext_vector_type(4)));
#define WAVE_SYNC() asm volatile("s_waitcnt lgkmcnt(0)" ::: "memory")

constexpr int MT = 8192, SEQ = 4096, DM = 2048, FF = 5504, INC = 5376, RWC = 2560;
constexpr int NPL = 16, NPH = 1 + 2 * NPL;
constexpr int LDS_BYTES = 147456;
constexpr size_t MiB = 1u << 20;
constexpr size_t SZ_WGU = (size_t)11008 * 2048 * 2, SZ_WD = (size_t)2048 * 5504 * 2, SZ_WIN = (size_t)5376 * 2048 * 2, SZ_WOUT = (size_t)2048 * 2048 * 2;
constexpr size_t SZ_WLORA = (size_t)2304 * 256 * 2, SZ_WGLU = (size_t)512 * 512 * 2, SZ_S5TAB = (size_t)(32 * 64 * 2 + 32 * 64 * 32) * 4;
constexpr size_t WS_WGU = 1 * MiB;
constexpr size_t WS_WD = WS_WGU + 4 * SZ_WGU;
constexpr size_t WS_WIN = WS_WD + 4 * SZ_WD;
constexpr size_t WS_WOUT = WS_WIN + 2 * SZ_WIN;
constexpr size_t WS_WLORA = WS_WOUT + 2 * SZ_WOUT;
constexpr size_t WS_WGLU = WS_WLORA + 2 * SZ_WLORA;
constexpr size_t WS_S5TAB = WS_WGLU + 2 * SZ_WGLU;
constexpr size_t WS_XB = ((WS_S5TAB + 2 * SZ_S5TAB + MiB - 1) / MiB) * MiB;
constexpr size_t WS_RS = WS_XB + 32 * MiB;
constexpr size_t WS_YCAT = WS_RS + 1 * MiB;
constexpr size_t WS_BIG = WS_YCAT + 32 * MiB;
constexpr size_t WS_ACT = WS_BIG, WS_H = WS_BIG + 96 * MiB;
constexpr size_t WS_ZR = WS_BIG, WS_DAQK = WS_BIG + 80 * MiB, WS_VT = WS_BIG + 104 * MiB, WS_ZS = WS_BIG + 116 * MiB, WS_LA = WS_BIG + 132 * MiB;
constexpr size_t WS_LR = WS_BIG + 136 * MiB, WS_SEND = WS_BIG + 208 * MiB, WS_SIN = WS_BIG + 232 * MiB;
constexpr size_t WS_YS = WS_BIG + 244 * MiB, WS_YSB = WS_BIG + 260 * MiB, WS_XE = WS_BIG + 268 * MiB, WS_XIN = WS_BIG + 269 * MiB;
constexpr size_t WS_YL = WS_BIG + 172 * MiB, WS_BON = WS_BIG + 196 * MiB, WS_QQ = WS_BIG + 270 * MiB, WS_END = WS_BIG + 294 * MiB;
static_assert(WS_END <= 700 * MiB, "workspace budget");

struct Params { const float* in[39]; float* out; unsigned char* ws; int ph_lo, ph_hi; };

#define DPPF(v, ctrl) __builtin_bit_cast(float, __builtin_amdgcn_mov_dpp(__builtin_bit_cast(int, (v)), (ctrl), 0xf, 0xf, true))
__device__ __forceinline__ float wave_sum(float v) {
    v += DPPF(v, 0xB1); v += DPPF(v, 0x4E); v += DPPF(v, 0x124); v += DPPF(v, 0x128);
    const float r0 = __builtin_bit_cast(float, __builtin_amdgcn_readlane(__builtin_bit_cast(int, v), 0)), r1 = __builtin_bit_cast(float, __builtin_amdgcn_readlane(__builtin_bit_cast(int, v), 16));
    const float r2 = __builtin_bit_cast(float, __builtin_amdgcn_readlane(__builtin_bit_cast(int, v), 32)), r3 = __builtin_bit_cast(float, __builtin_amdgcn_readlane(__builtin_bit_cast(int, v), 48));
    return (r0 + r1) + (r2 + r3);
}
__device__ __forceinline__ float sigmoidf_(float x) { return __builtin_amdgcn_rcpf(1.0f + __expf(-x)); }
__device__ __forceinline__ float dot4(f32x4 a, f32x4 b) { return (a.x * b.x + a.y * b.y) + (a.z * b.z + a.w * b.w); }

struct EpiGU {
    static constexpr bool PERM = true, AFTER_DRAIN = false;
    bf16_t* ACT; const float* rs;
    __device__ __forceinline__ void operator()(const f32x4 (&acc)[2][2][4][2], const Unit& u, int wr, int wc, int fr, int fq) const {
        const int row0 = u.pm * 256 + wr * 64 + fr, col0 = u.pn * 128 + wc * 32 + fq * 8;
        float sv[2][4];
#pragma unroll
        for (int ai = 0; ai < 2; ++ai)
#pragma unroll
            for (int m = 0; m < 4; ++m) sv[ai][m] = rs[row0 + ai * 128 + m * 16];
#pragma unroll
        for (int ai = 0; ai < 2; ++ai)
#pragma unroll
            for (int m = 0; m < 4; ++m) {
                const int row = row0 + ai * 128 + m * 16; const float s = sv[ai][m];
                float o[8];
#pragma unroll
                for (int n = 0; n < 2; ++n)
#pragma unroll
                    for (int j = 0; j < 4; ++j) { const float g = acc[ai][0][m][n][j] * s, up = acc[ai][1][m][n][j] * s; o[n * 4 + j] = g * sigmoidf_(g) * up; }
                u32x4 w; w.x = cvt_pk_bf16(o[0], o[1]); w.y = cvt_pk_bf16(o[2], o[3]); w.z = cvt_pk_bf16(o[4], o[5]); w.w = cvt_pk_bf16(o[6], o[7]);
                *(u32x4*)(ACT + (size_t)row * FF + col0) = w;
            }
    }
};
#define BF2F(x) __builtin_bit_cast(float, ((unsigned)(x)) << 16)
struct EpiBF {
    static constexpr bool PERM = true, AFTER_DRAIN = false;
    bf16_t* C; int ldc;
    __device__ __forceinline__ void operator()(const f32x4 (&acc)[2][2][4][2], const Unit& u, int wr, int wc, int fr, int fq) const {
        const int row0 = u.pm * 256 + wr * 64 + fr, col0 = u.pn * 256 + wc * 32 + fq * 8;
#pragma unroll
        for (int ai = 0; ai < 2; ++ai)
#pragma unroll
            for (int m = 0; m < 4; ++m)
#pragma unroll
                for (int bj = 0; bj < 2; ++bj) {
                    const f32x4 v0 = acc[ai][bj][m][0], v1 = acc[ai][bj][m][1];
                    u32x4 w; w.x = cvt_pk_bf16(v0[0], v0[1]); w.y = cvt_pk_bf16(v0[2], v0[3]); w.z = cvt_pk_bf16(v1[0], v1[1]); w.w = cvt_pk_bf16(v1[2], v1[3]);
                    *(u32x4*)(C + (size_t)(row0 + ai * 128 + m * 16) * ldc + col0 + bj * 128) = w;
                }
    }
};
struct EpiIN {
    static constexpr bool PERM = true, AFTER_DRAIN = false;
    float* ZR; bf16_t* DAQK; bf16_t* VT; float* ZS; const float* rs;
    __device__ __forceinline__ void operator()(const f32x4 (&acc)[2][2][4][2], const Unit& u, int wr, int wc, int fr, int fq) const {
        const int row0 = u.pm * 256 + wr * 64 + fr, cl0 = wc * 32 + fq * 8; const int pn = u.pn;
        float sv[2][4];
#pragma unroll
        for (int ai = 0; ai < 2; ++ai)
#pragma unroll
            for (int m = 0; m < 4; ++m) sv[ai][m] = rs[row0 + ai * 128 + m * 16];
#pragma unroll
        for (int ai = 0; ai < 2; ++ai)
#pragma unroll
            for (int m = 0; m < 4; ++m) {
                const int row = row0 + ai * 128 + m * 16; const float s = sv[ai][m];
#pragma unroll
                for (int bj = 0; bj < 2; ++bj) {
                    const f32x4 v0 = acc[ai][bj][m][0] * s, v1 = acc[ai][bj][m][1] * s; const int cl = cl0 + bj * 128;
                    if (pn < 10) { float* p = ZR + (size_t)row * RWC + pn * 256 + cl; *(f32x4*)p = v0; *(f32x4*)(p + 4) = v1; }
                    else if (pn < 16) { const float sc = (pn < 13) ? 0.18033688011112042f : 1.0f;
                        u32x4 w; w.x = cvt_pk_bf16(v0[0] * sc, v0[1] * sc); w.y = cvt_pk_bf16(v0[2] * sc, v0[3] * sc); w.z = cvt_pk_bf16(v1[0] * sc, v1[1] * sc); w.w = cvt_pk_bf16(v1[2] * sc, v1[3] * sc);
                        *(u32x4*)(DAQK + (size_t)row * 1536 + (pn - 10) * 256 + cl) = w; }
                    else if (pn < 19) { const int b = row >> 12, t = row & 4095; bf16_t* p = VT + ((size_t)(b * 768 + (pn - 16) * 256 + cl)) * SEQ + t;
#pragma unroll
                        for (int j = 0; j < 4; ++j) { p[(size_t)j * SEQ] = (bf16_t)(cvt_pk_bf16(v0[j], 0.f) & 0xffffu); p[(size_t)(j + 4) * SEQ] = (bf16_t)(cvt_pk_bf16(v1[j], 0.f) & 0xffffu); } }
                    else { float* p = ZS + (size_t)row * 512 + (pn - 19) * 256 + cl; *(f32x4*)p = v0; *(f32x4*)(p + 4) = v1; }
                }
            }
    }
};
__device__ __forceinline__ float decay_of(float x) {
    return __expf(-0.6065306597126334f * sigmoidf_(x));
}
struct EpiGLU {
    static constexpr bool PERM = true, AFTER_DRAIN = false;
    bf16_t* YCAT; const float* YS; const float* bglu;
    __device__ __forceinline__ void operator()(const f32x4 (&acc)[2][2][4][2], const Unit& u, int wr, int wc, int fr, int fq) const {
        const int row0 = u.pm * 256 + wr * 64 + fr, col0 = u.pn * 256 + wc * 32 + fq * 8;
#pragma unroll
        for (int bj = 0; bj < 2; ++bj) {
            const int c = col0 + bj * 128;
            const f32x4 b0 = *(const f32x4*)(bglu + c), b1 = *(const f32x4*)(bglu + c + 4);
#pragma unroll
            for (int ai = 0; ai < 2; ++ai)
#pragma unroll
                for (int m = 0; m < 4; ++m) {
                    const int row = row0 + ai * 128 + m * 16;
                    const f32x4 y0 = *(const f32x4*)(YS + (size_t)row * 512 + c), y1 = *(const f32x4*)(YS + (size_t)row * 512 + c + 4);
                    const f32x4 a0 = acc[ai][bj][m][0] + b0, a1 = acc[ai][bj][m][1] + b1;
                    float o[8];
#pragma unroll
                    for (int j = 0; j < 4; ++j) { o[j] = y0[j] * sigmoidf_(a0[j]); o[4 + j] = y1[j] * sigmoidf_(a1[j]); }
                    u32x4 w; w.x = cvt_pk_bf16(o[0], o[1]); w.y = cvt_pk_bf16(o[2], o[3]); w.z = cvt_pk_bf16(o[4], o[5]); w.w = cvt_pk_bf16(o[6], o[7]);
                    *(u32x4*)(YCAT + (size_t)row * DM + 1536 + c) = w;
                }
        }
    }
};
__device__ __forceinline__ void transpose_tile(const float* src, int ld, int K, const float* gvec, bf16_t* dst, int kt, int nt, int mode, LAS float* tl) {
    const int tid = tidx(); const int k0 = kt * 128, n0 = nt * 256;
    f32x4 v[16];
    const int j = (tid & 63) * 4; const int sc = (mode == 1) ? ((j < 128) ? nt * 128 + j : FF + nt * 128 + j - 128) : n0 + j;
    const float* sp = src + (size_t)(k0 + (tid >> 6)) * ld + sc;
#pragma unroll
    for (int i = 0; i < 16; ++i) v[i] = *(const f32x4*)(sp + (size_t)(8 * i) * ld);
#pragma unroll
    for (int i = 0; i < 16; ++i) {
        const int row = (tid >> 6) + 8 * i;
        const float g = gvec ? gvec[k0 + row] : 1.f;
        const int sw = ((row >> 3) & 15) << 1; LAS float* q = tl + row * 256;
        q[(j) ^ sw] = v[i].x * g; q[(j + 1) ^ sw] = v[i].y * g; q[(j + 2) ^ sw] = v[i].z * g; q[(j + 3) ^ sw] = v[i].w * g;
    }
    __syncthreads();
#pragma unroll
    for (int jj = 0; jj < 8; ++jj) {
        const int c = tid + 512 * jj; const int n = c >> 4, kc = c & 15;
        float x[8];
#pragma unroll
        for (int i = 0; i < 8; ++i) x[i] = tl[(kc * 8 + i) * 256 + (n ^ (kc << 1))];
        u32x4 w; w.x = cvt_pk_bf16(x[0], x[1]); w.y = cvt_pk_bf16(x[2], x[3]); w.z = cvt_pk_bf16(x[4], x[5]); w.w = cvt_pk_bf16(x[6], x[7]);
        *(u32x4*)(dst + (size_t)(n0 + n) * K + k0 + kc * 8) = w;
    }
    __syncthreads();
}

__device__ __forceinline__ void row_phase(const bf16_t* H, const float* xin, float* Xout, bf16_t* XB, float* RS, const float* g, float c, int wave, int lane, int m_begin = -1, int m_count = 0) {
    const int mb = (m_begin < 0) ? bidx() * 8 + wave : m_begin + wave, me = (m_begin < 0) ? MT : m_begin + m_count, mstep = (m_begin < 0) ? gridDim.x * 8 : 8;
#define BFX4(w) (f32x4){__builtin_bit_cast(float, (w).x << 16), __builtin_bit_cast(float, (w).x & 0xffff0000u), __builtin_bit_cast(float, (w).y << 16), __builtin_bit_cast(float, (w).y & 0xffff0000u)}
    if (H) {
        for (int m = mb; m < me; m += 2 * mstep) {
            const int m2 = (m + mstep < me) ? m + mstep : m;
            u32x2 hw[2][8], xw[2][8];
#pragma unroll
            for (int i = 0; i < 8; ++i) { const int o = (lane + 64 * i) * 4;
                hw[0][i] = *(const u32x2*)(H + (size_t)m * DM + o); xw[0][i] = *(const u32x2*)(XB + (size_t)m * DM + o);
                hw[1][i] = *(const u32x2*)(H + (size_t)m2 * DM + o); xw[1][i] = *(const u32x2*)(XB + (size_t)m2 * DM + o); }
#pragma unroll
            for (int r = 0; r < 2; ++r) {
                const int mr = r ? m2 : m;
                if (r == 1 && m2 == m) break;
                float ss = 0.f;
#pragma unroll
                for (int i = 0; i < 8; ++i) { const f32x4 hh = BFX4(hw[r][i]); ss += dot4(hh, hh); }
                ss = wave_sum(ss); const float rstd = rsqrtf(ss * (1.0f / DM) + 1e-6f) * c;
                float s2 = 0.f;
#pragma unroll
                for (int i = 0; i < 8; ++i) {
                    const size_t o = (size_t)mr * DM + (lane + 64 * i) * 4;
                    const f32x4 hh = BFX4(hw[r][i]); f32x4 x = BFX4(xw[r][i]);
                    const f32x4 gg = *(const f32x4*)(g + (lane + 64 * i) * 4); x = x + hh * rstd * gg;
                    if (Xout) *(f32x4*)(Xout + o) = x;
                    s2 += dot4(x, x);
                    u32x2 w; w.x = cvt_pk_bf16(x.x, x.y); w.y = cvt_pk_bf16(x.z, x.w); *(u32x2*)(XB + o) = w;
                }
                s2 = wave_sum(s2);
                if (lane == 0) RS[mr] = rsqrtf(s2 * (1.0f / DM) + 1e-6f);
            }
        }
    } else {
        for (int m = mb; m < me; m += mstep) {
            float s2 = 0.f;
#pragma unroll
            for (int i = 0; i < 8; ++i) {
                const size_t o = (size_t)m * DM + (lane + 64 * i) * 4;
                const f32x4 x = *(const f32x4*)(xin + o);
                if (Xout) *(f32x4*)(Xout + o) = x;
                s2 += dot4(x, x);
                u32x2 w; w.x = cvt_pk_bf16(x.x, x.y); w.y = cvt_pk_bf16(x.z, x.w); *(u32x2*)(XB + o) = w;
            }
            s2 = wave_sum(s2);
            if (lane == 0) RS[m] = rsqrtf(s2 * (1.0f / DM) + 1e-6f);
        }
    }
#undef BFX4
}

__device__ __forceinline__ void weight_tile(const Params& p, int gt, LAS unsigned char* lds) {
    unsigned char* ws = p.ws;
    const int l = gt / 2536; int r = gt - l * 2536;
    const float* src; int ld, K, ntn, mode = 0; const float* gv = nullptr; bf16_t* dst;
    if (r < 1376) { const int which = r >= 688; r -= which * 688; src = p.in[which ? 36 : 2] + (size_t)l * DM * 2 * FF; ld = 2 * FF; K = DM; ntn = 43; mode = 1; gv = p.in[which ? 35 : 1] + l * DM; dst = (bf16_t*)(ws + WS_WGU + (size_t)(l * 2 + which) * SZ_WGU); }
    else if (r < 2064) { r -= 1376; const int which = r >= 344; r -= which * 344; src = p.in[which ? 37 : 3] + (size_t)l * FF * DM; ld = DM; K = FF; ntn = 8; dst = (bf16_t*)(ws + WS_WD + (size_t)(l * 2 + which) * SZ_WD); }
    else if (r < 2400) { r -= 2064; src = p.in[6] + (size_t)l * DM * INC; ld = INC; K = DM; ntn = 21; gv = p.in[5] + l * DM; dst = (bf16_t*)(ws + WS_WIN + (size_t)l * SZ_WIN); }
    else if (r < 2528) { r -= 2400; src = p.in[33] + (size_t)l * DM * DM; ld = DM; K = DM; ntn = 8; dst = (bf16_t*)(ws + WS_WOUT + (size_t)l * SZ_WOUT); }
    else { r -= 2528; src = p.in[31] + (size_t)l * 512 * 512; ld = 512; K = 512; ntn = 2; dst = (bf16_t*)(ws + WS_WGLU + (size_t)l * SZ_WGLU); }
    const int kt = r / ntn, nt = r - kt * ntn;
    transpose_tile(src, ld, K, gv, dst, kt, nt, mode, (LAS float*)lds);
}

__device__ __forceinline__ void prologue(const Params& p, LAS unsigned char* lds, int wave, int lane) {
    unsigned char* ws = p.ws; const int tid = tidx(); const int G = gridDim.x;
    for (int gt = bidx(); gt < 2 * 2536 - 1376; gt += G) weight_tile(p, (gt < 2536) ? gt : gt + 1376, lds);
    if (bidx() == 0) ((unsigned*)ws)[tid] = 0u;
    for (int idx = bidx() * 512 + tid; idx < 2 * 2304 * 256; idx += G * 512) {
        const int l = idx / (2304 * 256); const int r = idx - l * (2304 * 256); const int n = r >> 8, k = r & 255;
        float v = 0.f;
        if (n < 768) { if (k < 64) v = p.in[9][((size_t)l * 64 + k) * 768 + n]; }
        else if (n < 1536) { if (k >= 64 && k < 128) v = p.in[11][((size_t)l * 64 + (k - 64)) * 768 + (n - 768)]; }
        else { if (k >= 128) v = p.in[12][((size_t)l * 128 + (k - 128)) * 768 + (n - 1536)]; }
        ((bf16_t*)(ws + WS_WLORA))[idx] = (bf16_t)(cvt_pk_bf16(v, 0.f) & 0xffffu);
    }
    for (int idx = bidx() * 512 + tid; idx < 2 * 2048; idx += G * 512) {
        const int l = idx >> 11, gn = idx & 2047, g = gn >> 6;
        float* tab = (float*)(ws + WS_S5TAB + (size_t)l * SZ_S5TAB);
        const float dt = expf(p.in[25][l * 32 + g]); const float ar = p.in[23][l * 2048 + gn], ai = p.in[24][l * 2048 + gn];
        const float mag = expf(dt * ar); const float abr = mag * cosf(dt * ai), abi = mag * sinf(dt * ai);
        const float den = ar * ar + ai * ai; const float nr = abr - 1.0f, ni = abi;
        const float cr = (nr * ar + ni * ai) / den, ci = (ni * ar - nr * ai) / den;
        tab[gn * 2] = abr; tab[gn * 2 + 1] = abi;
        const float* br = p.in[26] + ((size_t)l * 2048 + gn) * 16; const float* bi = p.in[27] + ((size_t)l * 2048 + gn) * 16;
#pragma unroll
        for (int c = 0; c < 16; ++c) { tab[4096 + gn * 32 + c * 2] = cr * br[c] - ci * bi[c]; tab[4096 + gn * 32 + c * 2 + 1] = cr * bi[c] + ci * br[c]; }
    }
    row_phase(nullptr, p.in[0], nullptr, (bf16_t*)(ws + WS_XB), (float*)(ws + WS_RS), nullptr, 0.f, wave, lane);
}

__device__ __forceinline__ void la_prep(const Params& p, int l) {
    const float* ZR = (const float*)(p.ws + WS_ZR); bf16_t* LA = (bf16_t*)(p.ws + WS_LA); const float* mu = p.in[7] + l * RWC;
    for (int idx = bidx() * 512 + tidx(); idx < MT * 64; idx += gridDim.x * 512) {
        const int m = idx >> 6, c4 = (idx & 63) * 4; const int col = 2304 + c4;
        const f32x4 zc = *(const f32x4*)(ZR + (size_t)m * RWC + col);
        f32x4 zp = {0.f, 0.f, 0.f, 0.f}; if (m & (SEQ - 1)) zp = *(const f32x4*)(ZR + (size_t)(m - 1) * RWC + col);
        const f32x4 m4 = *(const f32x4*)(mu + col);
        f32x4 z = zc + (zp - zc) * m4;
        if (c4 < 64) { z.x = tanhf(z.x); z.y = tanhf(z.y); z.z = tanhf(z.z); z.w = tanhf(z.w); }
        else if (c4 >= 128) { z.x = sigmoidf_(z.x); z.y = sigmoidf_(z.y); z.z = sigmoidf_(z.z); z.w = sigmoidf_(z.w); }
        u32x2 w; w.x = cvt_pk_bf16(z.x, z.y); w.y = cvt_pk_bf16(z.z, z.w);
        *(u32x2*)(LA + (size_t)m * 256 + c4) = w;
    }
}

__device__ __forceinline__ float gelu_tanh(float x) { const float t = tanhf(0.7978845608028654f * (x + 0.044715f * x * x * x)); return 0.5f * x * (1.0f + t); }

template <int PASS>
__device__ __forceinline__ void s5_scan(const Params& p, int l, int widx, int nw, int beff, int nblk, int lane, LAS unsigned char* lds) {
    if (widx < 0 || widx >= nw || beff < 0) return;
    unsigned char* ws = p.ws;
    LAS float* ub = (LAS float*)(lds + widx * 19456);
    LAS float* xb = ub + 512;
    LAS float* ct = xb + 16 * 132;
    const float* ZS = (const float*)(ws + WS_ZS); const float* tab = (const float*)(ws + WS_S5TAB + (size_t)l * SZ_S5TAB);
    float* XE = (float*)(ws + WS_XE);
    float* YS = (float*)(ws + WS_YS); bf16_t* YSB = (bf16_t*)(ws + WS_YSB);
    for (int u = widx * nblk + beff; u < 1024; u += nw * nblk) {
        const int c = u & 15, g = (u >> 4) & 31, b = u >> 9; const int gn = g * 64 + lane;
        const float ar = tab[gn * 2], ai = tab[gn * 2 + 1];
        float br[16], bi[16];
#pragma unroll
        for (int q = 0; q < 8; ++q) { const f32x4 v = *(const f32x4*)(tab + 4096 + gn * 32 + q * 4); br[2 * q] = v.x; bi[2 * q] = v.y; br[2 * q + 1] = v.z; bi[2 * q + 1] = v.w; }
        float xr = 0.f, xi = 0.f;
        if (PASS == 2) {
            float pr = ar, pi = ai;
#pragma unroll
            for (int i = 0; i < 8; ++i) { const float r2 = pr * pr - pi * pi, i2 = 2.f * pr * pi; pr = r2; pi = i2; }
            for (int cp = 0; cp < c; ++cp) { const int up = (u & ~15) + cp; const float er = XE[(up * 64 + lane) * 2], ei = XE[(up * 64 + lane) * 2 + 1];
                const float nr = pr * xr - pi * xi + er, ni = pr * xi + pi * xr + ei; xr = nr; xi = ni; }
#pragma unroll
            for (int cc = 0; cc < 16; ++cc) { ct[cc * 132 + lane] = p.in[28][((size_t)l * 32 + g) * 1024 + cc * 64 + lane]; ct[cc * 132 + 64 + lane] = -p.in[29][((size_t)l * 32 + g) * 1024 + cc * 64 + lane]; }
        }
        const int m0 = b * SEQ + c * 256;
        f32x4 un = *(const f32x4*)(ZS + (size_t)(m0 + (lane >> 2)) * 512 + g * 16 + (lane & 3) * 4);
        for (int bt = 0; bt < 16; ++bt) {
            LAS float* ubc = ub + (bt & 1) * 256;
            *(LAS f32x4*)(ubc + lane * 4) = un;
            if (bt + 1 < 16) un = *(const f32x4*)(ZS + (size_t)(m0 + (bt + 1) * 16 + (lane >> 2)) * 512 + g * 16 + (lane & 3) * 4);
            WAVE_SYNC();
#pragma unroll 4
            for (int s = 0; s < 16; ++s) {
                const f32x4 u0 = *(LAS f32x4*)(ubc + s * 16), u1 = *(LAS f32x4*)(ubc + s * 16 + 4), u2 = *(LAS f32x4*)(ubc + s * 16 + 8), u3 = *(LAS f32x4*)(ubc + s * 16 + 12);
                float bur = 0.f, bui = 0.f;
#pragma unroll
                for (int j = 0; j < 4; ++j) { bur += br[j] * u0[j]; bui += bi[j] * u0[j]; }
#pragma unroll
                for (int j = 0; j < 4; ++j) { bur += br[4 + j] * u1[j]; bui += bi[4 + j] * u1[j]; }
#pragma unroll
                for (int j = 0; j < 4; ++j) { bur += br[8 + j] * u2[j]; bui += bi[8 + j] * u2[j]; }
#pragma unroll
                for (int j = 0; j < 4; ++j) { bur += br[12 + j] * u3[j]; bui += bi[12 + j] * u3[j]; }
                const float nxr = ar * xr - ai * xi + bur, nxi = ar * xi + ai * xr + bui; xr = nxr; xi = nxi;
                if (PASS == 2) { xb[s * 132 + lane] = xr; xb[s * 132 + 64 + lane] = xi; }
            }
            if (PASS == 2) {
                WAVE_SYNC();
                const int s = lane >> 2, c4 = lane & 3;
                f32x4 y = {0.f, 0.f, 0.f, 0.f};
#pragma unroll 4
                for (int n4 = 0; n4 < 32; ++n4) {
                    const f32x4 xv = *(LAS f32x4*)(xb + s * 132 + n4 * 4);
#pragma unroll
                    for (int j = 0; j < 4; ++j) { const f32x4 cv = *(LAS f32x4*)(ct + (c4 * 4 + j) * 132 + n4 * 4); y[j] += dot4(xv, cv); }
                }
                const f32x4 uu = *(LAS f32x4*)(ubc + s * 16 + c4 * 4);
                const f32x4 dsk = *(const f32x4*)(p.in[30] + l * 512 + g * 16 + c4 * 4);
                y = y + dsk * uu;
                y.x = gelu_tanh(y.x); y.y = gelu_tanh(y.y); y.z = gelu_tanh(y.z); y.w = gelu_tanh(y.w);
                const size_t o = (size_t)(m0 + bt * 16 + s) * 512 + g * 16 + c4 * 4;
                *(f32x4*)(YS + o) = y;
                u32x2 w; w.x = cvt_pk_bf16(y.x, y.y); w.y = cvt_pk_bf16(y.z, y.w); *(u32x2*)(YSB + o) = w;
                WAVE_SYNC();
            }
        }
        if (PASS == 1) { XE[(u * 64 + lane) * 2] = xr; XE[(u * 64 + lane) * 2 + 1] = xi; }
    }
}
__device__ __forceinline__ void s5_combine(const Params& p, int l, int unit0, int ustride, int lane) {
    const float* tab = (const float*)(p.ws + WS_S5TAB + (size_t)l * SZ_S5TAB); const float* XE = (const float*)(p.ws + WS_XE); float* XIN = (float*)(p.ws + WS_XIN);
    for (int bg = unit0; bg < 64; bg += ustride) {
        const int g = bg & 31; float ar = tab[(g * 64 + lane) * 2], ai = tab[(g * 64 + lane) * 2 + 1];
#pragma unroll
        for (int i = 0; i < 8; ++i) { const float r2 = ar * ar - ai * ai, i2 = 2.f * ar * ai; ar = r2; ai = i2; }
        float xr = 0.f, xi = 0.f; asm volatile("" : "+v"(xr), "+v"(xi));
        for (int c = 0; c < 16; ++c) {
            const int u = bg * 16 + c;
            XIN[(u * 64 + lane) * 2] = xr; XIN[(u * 64 + lane) * 2 + 1] = xi;
            const float er = XE[(u * 64 + lane) * 2], ei = XE[(u * 64 + lane) * 2 + 1];
            const float nr = ar * xr - ai * xi + er, ni = ar * xi + ai * xr + ei; xr = nr; xi = ni;
        }
    }
}
template <int PASS>
__device__ __forceinline__ void rwkv_scan(const Params& p, int l, int wave, int lane, LAS unsigned char* lds) {
    if (wave >= 3) return;
    constexpr int NB = 2, NBT = 128 / NB;
    const int G = gridDim.x; unsigned char* ws = p.ws;
    LAS float* sb = (LAS float*)(lds + wave * 8192);
    LAS float* cb = sb + 1024 + lane;
    const float* ZR = (const float*)(ws + WS_ZR); const bf16_t* LR = (const bf16_t*)(ws + WS_LR);
    const float* SIN = (const float*)(ws + WS_SIN); bf16_t* YCAT = (bf16_t*)(ws + WS_YCAT);
    for (int u = wave * G + bidx(); u < 768; u += 3 * G) {
        const int c = u & 31, bh = u >> 5; const int b = bh / 12, h = bh - b * 12; const int ch = h * 64 + lane;
        const int m0 = b * SEQ + c * 128;
        cb[0] = p.in[7][l * RWC + ch]; cb[64] = p.in[7][l * RWC + 768 + ch]; cb[128] = p.in[7][l * RWC + 1536 + ch];
        cb[192] = p.in[13][l * 768 + ch]; cb[256] = p.in[14][l * 768 + ch]; cb[320] = p.in[8][l * 768 + ch]; cb[384] = p.in[10][l * 768 + ch];
        cb[448] = p.in[15][l * 768 + ch];
        if (PASS == 2) { cb[512] = p.in[16][l * 768 + ch]; cb[576] = p.in[17][l * 768 + ch]; }
        f32x2 s[32]; f32x2 pp[32];
        if (PASS == 1) {
#pragma unroll
            for (int j = 0; j < 32; ++j) { int ll = lane; asm volatile("" : "+v"(ll)); s[j] = (f32x2){0.f, 0.f}; pp[j] = (f32x2){(2 * j == ll) ? 1.f : 0.f, (2 * j + 1 == ll) ? 1.f : 0.f}; }
        } else {
#pragma unroll
            for (int j = 0; j < 32; ++j) { s[j] = (f32x2){SIN[((size_t)u * 64 + 2 * j) * 64 + lane], SIN[((size_t)u * 64 + 2 * j + 1) * 64 + lane]}; }
        }
        float pr = 0.f, pk = 0.f, pv = 0.f;
        if (c != 0) { const float* zp = ZR + (size_t)(m0 - 1) * RWC; pr = zp[ch]; pk = zp[768 + ch]; pv = zp[1536 + ch]; }
        float zr4[NB], zk4[NB], zv4[NB], de4[NB], aa4[NB], gg4[NB];
#pragma unroll
        for (int q = 0; q < NB; ++q) { const float* zb = ZR + (size_t)(m0 + q) * RWC; const bf16_t* lb = LR + (size_t)(m0 + q) * 2304; zr4[q] = zb[ch]; zk4[q] = (zb + 768)[ch]; zv4[q] = (zb + 1536)[ch]; de4[q] = BF2F(lb[ch]); aa4[q] = BF2F((lb + 768)[ch]); gg4[q] = (PASS == 2) ? BF2F((lb + 1536)[ch]) : 0.f; }
        for (int bt = 0; bt < NBT; ++bt) {
            float vv[NB];
            const float mu_r = cb[0], mu_k = cb[64], mu_v = cb[128], kkc = cb[192], kac = cb[256], w0c = cb[320], a0c = cb[384]; const float rkc = cb[448];
#pragma unroll
            for (int q = 0; q < NB; ++q) {
                const float r = zr4[q] + (pr - zr4[q]) * mu_r, k = zk4[q] + (pk - zk4[q]) * mu_k, v = zv4[q] + (pv - zv4[q]) * mu_v;
                pr = zr4[q]; pk = zk4[q]; pv = zv4[q];
                float kk = k * kkc; const float n2 = wave_sum(kk * kk); kk = kk * __builtin_amdgcn_rcpf(fmaxf(__builtin_amdgcn_sqrtf(n2), 1e-12f));
                const float a = sigmoidf_(a0c + aa4[q]); const float kmod = k * (1.0f + (a - 1.0f) * kac);
                LAS float* q5 = sb + q * 512 + lane;
                q5[0] = decay_of(w0c + de4[q]); q5[64] = -kk; q5[128] = kk * a; q5[192] = kmod; q5[256] = r; q5[320] = v;
                vv[q] = v;
                if (PASS == 2) { q5[384] = wave_sum(r * kmod * rkc) * v; q5[448] = gg4[q]; }
                if (PASS == 1) { const float bo = wave_sum(r * kmod * rkc) * v; ((bf16_t*)(ws + WS_BON))[(size_t)(m0 + bt * NB + q) * 768 + ch] = (bf16_t)(cvt_pk_bf16(bo, 0.f) & 0xffffu); }
            }
            if (bt + 1 < NBT) {
#pragma unroll
                for (int q = 0; q < NB; ++q) { const float* zb = ZR + (size_t)(m0 + (bt + 1) * NB + q) * RWC; const bf16_t* lb = LR + (size_t)(m0 + (bt + 1) * NB + q) * 2304; zr4[q] = zb[ch]; zk4[q] = (zb + 768)[ch]; zv4[q] = (zb + 1536)[ch]; de4[q] = BF2F(lb[ch]); aa4[q] = BF2F((lb + 768)[ch]); gg4[q] = (PASS == 2) ? BF2F((lb + 1536)[ch]) : 0.f; }
            }
            WAVE_SYNC();
            float yo[NB];
#define SB_ __builtin_amdgcn_sched_barrier(0)
#define LDV(dst, n, src) _Pragma("unroll") for (int j_ = 0; j_ < (n); ++j_) dst[j_] = (src)[j_]
            if (PASS == 1) {
                f32x4 H3[3][4];
#define RW1_VEC(k) (((k) < 4) ? 16 : (((k) >= 16) ? 64 : (((((k) - 4) % 3) == 0) ? 0 : (((((k) - 4) % 3) == 1) ? 32 : 48))))
#define RW1_QTR(k) (((k) < 4) ? (k) : (((k) >= 16) ? ((k) - 16) : (((k) - 4) / 3)))
#define RW1_PTR(g) ((const LAS f32x4*)(sb + ((g) / 20) * 512) + RW1_VEC((g) % 20) + RW1_QTR((g) % 20) * 4)
                LDV(H3[0], 4, RW1_PTR(0)); LDV(H3[1], 4, RW1_PTR(1));
#pragma unroll
                for (int q = 0; q < NB; ++q) {
                    const float vq = sb[q * 512 + 320 + lane];
                    f32x2 as0, ap0, sas2, sap2; const f32x2 v2 = {vq, vq};
#pragma unroll
                    for (int k = 0; k < 20; ++k) {
                        const int g = q * 20 + k; const int c8 = RW1_QTR(k) * 8; const int t = (k < 4) ? -1 : ((k >= 16) ? 3 : ((k - 4) % 3));
                        if (g + 2 < NB * 20) { LDV(H3[(g + 2) % 3], 4, RW1_PTR(g + 2)); }
                        SB_;
#pragma unroll
                        for (int j = 0; j < 4; ++j) {
                            const f32x4 o4 = H3[g % 3][j]; const f32x2 lo = {o4.x, o4.y}, hi = {o4.z, o4.w};
                            if (t < 0) { if (k == 0 && j == 0) { as0 = s[c8] * lo; ap0 = pp[c8] * lo; } else { as0 += s[c8 + 2 * j] * lo; ap0 += pp[c8 + 2 * j] * lo; } as0 += s[c8 + 2 * j + 1] * hi; ap0 += pp[c8 + 2 * j + 1] * hi; }
                            else if (t == 0) { s[c8 + 2 * j] *= lo; s[c8 + 2 * j + 1] *= hi; pp[c8 + 2 * j] *= lo; pp[c8 + 2 * j + 1] *= hi; }
                            else if (t == 1) { s[c8 + 2 * j] += sas2 * lo; s[c8 + 2 * j + 1] += sas2 * hi; pp[c8 + 2 * j] += sap2 * lo; pp[c8 + 2 * j + 1] += sap2 * hi; }
                            else if (t == 2) { s[c8 + 2 * j] += v2 * lo; s[c8 + 2 * j + 1] += v2 * hi; }
                            else { if (k == 16 && j == 0) { as0 = s[c8] * lo; ap0 = pp[c8] * lo; } else { as0 += s[c8 + 2 * j] * lo; ap0 += pp[c8 + 2 * j] * lo; } as0 += s[c8 + 2 * j + 1] * hi; ap0 += pp[c8 + 2 * j + 1] * hi; }
                        }
                        if (k == 19) { const size_t o = (size_t)(m0 + bt * NB + q) * 768 + ch; ((float*)(ws + WS_YL))[o] = as0.x + as0.y; ((float*)(ws + WS_QQ))[o] = ap0.x + ap0.y; }
                        if (k == 3) { const float sas = as0.x + as0.y, sap = ap0.x + ap0.y; sas2 = (f32x2){sas, sas}; sap2 = (f32x2){sap, sap}; }
                        SB_;
                    }
                }
#undef RW1_PTR
#undef RW1_QTR
#undef RW1_VEC
            } else {
                f32x4 H3[2][8];
#define RW2_PTR(g) ((const LAS f32x4*)(sb + ((g) / 10) * 512) + ((((g) % 10) / 2 == 0) ? 16 : ((((g) % 10) / 2 == 1) ? 0 : ((((g) % 10) / 2 == 2) ? 32 : ((((g) % 10) / 2 == 3) ? 48 : 64)))) + ((g) % 2) * 8)
                LDV(H3[0], 8, RW2_PTR(0));
#pragma unroll
                for (int q = 0; q < NB; ++q) {
                    f32x2 as0, as1, ay0, ay1, sas2; const f32x2 v2 = {vv[q], vv[q]};
#pragma unroll
                    for (int k = 0; k < 10; ++k) {
                        const int g = q * 10 + k; const int h16 = (k & 1) * 16;
                        if (g + 1 < NB * 10) { LDV(H3[(g + 1) % 2], 8, RW2_PTR(g + 1)); }
                        SB_;
#pragma unroll
                        for (int j = 0; j < 8; ++j) {
                            const f32x4 o4 = H3[g % 2][j]; const f32x2 lo = {o4.x, o4.y}, hi = {o4.z, o4.w};
                            if (k < 2) { if (k == 0 && j == 0) { as0 = s[0] * lo; as1 = s[1] * hi; } else { as0 += s[h16 + 2 * j] * lo; as1 += s[h16 + 2 * j + 1] * hi; } }
                            else if (k < 4) { s[h16 + 2 * j] *= lo; s[h16 + 2 * j + 1] *= hi; }
                            else if (k < 6) { s[h16 + 2 * j] += sas2 * lo; s[h16 + 2 * j + 1] += sas2 * hi; }
                            else if (k < 8) { s[h16 + 2 * j] += v2 * lo; s[h16 + 2 * j + 1] += v2 * hi; }
                            else { if (k == 8 && j == 0) { ay0 = s[0] * lo; ay1 = s[1] * hi; } else { ay0 += s[h16 + 2 * j] * lo; ay1 += s[h16 + 2 * j + 1] * hi; } }
                        }
                        if (k == 1) { const float sas = (as0.x + as0.y) + (as1.x + as1.y); sas2 = (f32x2){sas, sas}; }
                        SB_;
                    }
                    yo[q] = (ay0.x + ay0.y) + (ay1.x + ay1.y);
                }
#undef RW2_PTR
            }
#undef SB_
#undef LDV
            if (PASS == 2) {
#pragma unroll
                for (int q = 0; q < NB; ++q) {
                    const float mean = wave_sum(yo[q]) * (1.0f / 64.0f); const float d = yo[q] - mean; const float var = wave_sum(d * d) * (1.0f / 64.0f);
                    const float gnw = cb[512], gnb = cb[576]; const float yn = d * rsqrtf(var + 64e-5f) * gnw + gnb; const float o = (yn + sb[q * 512 + 384 + lane]) * sb[q * 512 + 448 + lane];
                    YCAT[(size_t)(m0 + bt * NB + q) * DM + ch] = (bf16_t)(cvt_pk_bf16(o, 0.f) & 0xffffu);
                }
            }
            WAVE_SYNC();
        }
        if (PASS == 1) {
            int ll = lane; asm volatile("" : "+v"(ll));
            unsigned char* wsl = p.ws; asm volatile("" : "+s"(wsl)); int ul = u; asm volatile("" : "+s"(ul));
            float* sp = (float*)(wsl + WS_SEND) + (size_t)ul * 8192 + ll;
#pragma unroll
            for (int j = 0; j < 32; ++j) {
                sp[(2 * j) * 64] = s[j].x; sp[(2 * j + 1) * 64] = s[j].y;
                sp[(64 + 2 * j) * 64] = pp[j].x; sp[(64 + 2 * j + 1) * 64] = pp[j].y;
            }
        }
    }
}
__device__ __forceinline__ void rwkv_out(const Params& p, int l, int wave, int lane, LAS unsigned char* lds) {
    unsigned char* ws = p.ws; const int G = gridDim.x;
    const float* SIN = (const float*)(ws + WS_SIN); const float* YL = (const float*)(ws + WS_YL); const float* QQ = (const float*)(ws + WS_QQ);
    const bf16_t* BON = (const bf16_t*)(ws + WS_BON); const bf16_t* LR = (const bf16_t*)(ws + WS_LR); bf16_t* YCAT = (bf16_t*)(ws + WS_YCAT);
    LAS float* qb = (LAS float*)(lds + wave * 1024);
    for (int u2 = wave * G + bidx(); u2 < 3072; u2 += 8 * G) {
        const int u = u2 >> 2, qt = u2 & 3; const int c = u & 31, bh = u >> 5; const int b = bh / 12, h = bh - b * 12; const int ch = h * 64 + lane;
        const int m0 = b * SEQ + c * 128 + qt * 32;
        const float gnw = p.in[16][l * 768 + ch], gnb = p.in[17][l * 768 + ch];
        f32x2 s[32];
        { const float* sb_ = SIN + (size_t)u * 4096 + lane;
#pragma unroll
          for (int j = 0; j < 32; ++j) s[j] = (f32x2){sb_[(2 * j) * 64], sb_[(2 * j + 1) * 64]}; }
        float q4[4], y4[4], b4[4], g4[4];
#pragma unroll
        for (int q = 0; q < 4; ++q) { const size_t o = (size_t)(m0 + q) * 768; q4[q] = (QQ + o)[ch]; y4[q] = (YL + o)[ch]; b4[q] = BF2F((BON + o)[ch]); g4[q] = BF2F((LR + (size_t)(m0 + q) * 2304 + 1536)[ch]); }
        for (int bt = 0; bt < 8; ++bt) {
            float yc[4], bc[4], gc[4];
#pragma unroll
            for (int q = 0; q < 4; ++q) { qb[q * 64 + lane] = q4[q]; yc[q] = y4[q]; bc[q] = b4[q]; gc[q] = g4[q]; }
            if (bt + 1 < 8) {
#pragma unroll
                for (int q = 0; q < 4; ++q) { const size_t o = (size_t)(m0 + (bt + 1) * 4 + q) * 768; q4[q] = (QQ + o)[ch]; y4[q] = (YL + o)[ch]; b4[q] = BF2F((BON + o)[ch]); g4[q] = BF2F((LR + (size_t)(m0 + (bt + 1) * 4 + q) * 2304 + 1536)[ch]); }
            }
            WAVE_SYNC();
#pragma unroll
            for (int q = 0; q < 4; ++q) {
                const LAS f32x4* Q4 = (const LAS f32x4*)(qb + q * 64);
                f32x2 a0 = {0.f, 0.f}, a1 = {0.f, 0.f};
#pragma unroll
                for (int j = 0; j < 16; ++j) { const f32x4 v = Q4[j]; a0 += s[2 * j] * (f32x2){v.x, v.y}; a1 += s[2 * j + 1] * (f32x2){v.z, v.w}; }
                const float yo = yc[q] + (a0.x + a0.y) + (a1.x + a1.y);
                const float mean = wave_sum(yo) * (1.0f / 64.0f); const float d = yo - mean; const float var = wave_sum(d * d) * (1.0f / 64.0f);
                const float o = (d * rsqrtf(var + 64e-5f) * gnw + gnb + bc[q]) * gc[q];
                YCAT[(size_t)(m0 + bt * 4 + q) * DM + ch] = (bf16_t)(cvt_pk_bf16(o, 0.f) & 0xffffu);
            }
            WAVE_SYNC();
        }
    }
}
__device__ __forceinline__ void rwkv_combine(const Params& p, int bh, int wave, int lane, LAS unsigned char* lds) {
    LAS float* xs = (LAS float*)lds;
    LAS float* pw = (LAS float*)(lds + 16384 + wave * 2048);
    const float* SEND = (const float*)(p.ws + WS_SEND) + (size_t)bh * 32 * 8192 + (size_t)(wave * 8) * 64 + lane; float* SIN = (float*)(p.ws + WS_SIN) + (size_t)bh * 32 * 4096 + (size_t)(wave * 8) * 64 + lane;
    f32x2 s[32];
#pragma unroll
    for (int j = 0; j < 32; ++j) s[j] = (f32x2){0.f, 0.f};
    float own[8], pj[4][8], sl[4][8];
#pragma unroll
    for (int jj = 0; jj < 8; ++jj) own[jj] = 0.f;
#pragma unroll
    for (int d = 0; d < 4; ++d)
#pragma unroll
        for (int jj = 0; jj < 8; ++jj) { pj[d][jj] = SEND[(size_t)d * 8192 + (64 + jj) * 64]; sl[d][jj] = SEND[(size_t)d * 8192 + jj * 64]; }
    for (int c4 = 0; c4 < 8; ++c4) {
#pragma unroll
        for (int cc = 0; cc < 4; ++cc) {
            const int c = c4 * 4 + cc;
            float slc[8];
#pragma unroll
            for (int jj = 0; jj < 8; ++jj) { SIN[(size_t)c * 4096 + jj * 64] = own[jj]; pw[jj * 64 + lane] = pj[cc][jj]; slc[jj] = sl[cc][jj]; }
            if (c + 4 < 32) {
#pragma unroll
                for (int jj = 0; jj < 8; ++jj) { pj[cc][jj] = SEND[(size_t)(c + 4) * 8192 + (64 + jj) * 64]; sl[cc][jj] = SEND[(size_t)(c + 4) * 8192 + jj * 64]; }
            }
            WAVE_SYNC();
#pragma unroll
            for (int jj = 0; jj < 8; ++jj) {
                f32x2 a0 = {0.f, 0.f}, a1 = {0.f, 0.f};
#pragma unroll
                for (int i4 = 0; i4 < 16; ++i4) { const f32x4 pv = *(const LAS f32x4*)(pw + jj * 64 + i4 * 4); a0 += s[2 * i4] * (f32x2){pv.x, pv.y}; a1 += s[2 * i4 + 1] * (f32x2){pv.z, pv.w}; }
                own[jj] = slc[jj] + (a0.x + a0.y) + (a1.x + a1.y);
                xs[(wave * 8 + jj) * 64 + lane] = own[jj];
            }
            __syncthreads();
#pragma unroll
            for (int j = 0; j < 32; ++j) s[j] = (f32x2){xs[(2 * j) * 64 + lane], xs[(2 * j + 1) * 64 + lane]};
            __syncthreads();
        }
    }
}

constexpr int KP = 136, VP = 72;
constexpr int ATT_BUF = 64 * KP * 2 + 128 * VP * 2;
__device__ __forceinline__ void attn_phase(const Params& p, int l, int wave, int lane, LAS unsigned char* lds, int early) {
    const int tid = tidx(); unsigned char* ws = p.ws;
    const bf16_t* DAQK = (const bf16_t*)(ws + WS_DAQK); const bf16_t* VT = (const bf16_t*)(ws + WS_VT); bf16_t* YCAT = (bf16_t*)(ws + WS_YCAT);
    const float lam_init = 0.8f - 0.6f * expf(-0.3f * (float)l);
    const float d1 = wave_sum(p.in[18][l * 64 + lane] * p.in[19][l * 64 + lane]), d2 = wave_sum(p.in[20][l * 64 + lane] * p.in[21][l * 64 + lane]);
    const float lam = expf(d1) - expf(d2) + lam_init;
    const int sub = wave >> 2, rq = (wave & 3) * 32, qi = lane & 15, g4 = lane >> 4;
    const int x16 = (lane ^ 16) << 2, x32 = (lane ^ 32) << 2;
#define SHX(v, a) __builtin_bit_cast(float, __builtin_amdgcn_ds_bpermute((a), __builtin_bit_cast(int, (v))))
    unsigned* aq = (unsigned*)ws + 256 + l; unsigned* dn = (unsigned*)ws + 264 + l;
    volatile LAS int* ubox = (volatile LAS int*)(lds + 143360);
    LAS float* swl = (LAS float*)(lds + 143488);
    if (tid < 128) swl[tid] = p.in[22][l * 128 + tid] * (1.0f - lam_init);
    for (;;) {
        __syncthreads();
        if (tid == 0) { int un = 384;
            if (!(early && __hip_atomic_load(dn, __ATOMIC_RELAXED, __HIP_MEMORY_SCOPE_AGENT) >= 24u)) un = (int)__hip_atomic_fetch_add(aq, 1u, __ATOMIC_RELAXED, __HIP_MEMORY_SCOPE_AGENT);
            *ubox = un; }
        __syncthreads();
        const int u = *ubox;
        if (u >= 384) break;
        const int qb = 31 - u / 12, rem = u % 12, b = rem / 6, h = rem % 6;
        const int q0 = qb * 128, kl = 2 * qb + 1;
        bf16x8 qf[2][2];
#pragma unroll
        for (int rt = 0; rt < 2; ++rt) { const bf16_t* qp = DAQK + (size_t)(b * SEQ + q0 + rq + 16 * rt + qi) * 1536 + h * 128 + sub * 64 + g4 * 8; qf[rt][0] = *(const bf16x8*)qp; qf[rt][1] = *(const bf16x8*)(qp + 32); }
        f32x4 o[2][8];
#pragma unroll
        for (int rt = 0; rt < 2; ++rt)
#pragma unroll
            for (int e = 0; e < 8; ++e) o[rt][e] = (f32x4){0.f, 0.f, 0.f, 0.f};
        float mrun[2] = {-1e30f, -1e30f}, lrun[2] = {0.f, 0.f};
        const int kr0 = tid >> 4, kc0 = tid & 15;
        const int vr0 = tid >> 3, vc0 = tid & 7;
        const bf16_t* kbase = DAQK + (size_t)(b * SEQ) * 1536 + 768 + h * 128 + kc0 * 8;
        const bf16_t* vbase = VT + (size_t)(b * 768 + h * 128) * SEQ + vc0 * 8;
        u32x4 kreg[2], vreg[2];
#define ATT_LOADR(KR, VR, kb) do { KR[0] = *(const u32x4*)(kbase + (size_t)((kb) * 64 + kr0) * 1536); KR[1] = *(const u32x4*)(kbase + (size_t)((kb) * 64 + kr0 + 32) * 1536); \
        VR[0] = *(const u32x4*)(vbase + (size_t)vr0 * SEQ + (kb) * 64); VR[1] = *(const u32x4*)(vbase + (size_t)(vr0 + 64) * SEQ + (kb) * 64); } while (0)
#define ATT_STORER(KR, VR, buf) do { LAS unsigned char* kb_ = lds + (buf) * ATT_BUF; LAS unsigned char* vb_ = kb_ + 64 * KP * 2; \
        *(LAS u32x4*)(kb_ + (kr0 * KP + kc0 * 8) * 2) = KR[0]; *(LAS u32x4*)(kb_ + ((kr0 + 32) * KP + kc0 * 8) * 2) = KR[1]; \
        *(LAS u32x4*)(vb_ + (vr0 * VP + vc0 * 8) * 2) = VR[0]; *(LAS u32x4*)(vb_ + ((vr0 + 64) * VP + vc0 * 8) * 2) = VR[1]; } while (0)
#define ATT_COMPUTE(kb) do { \
            const LAS unsigned char* kt = lds + ((kb) & 1) * ATT_BUF; const LAS unsigned char* vt = kt + 64 * KP * 2; \
            f32x4 st[2][4]; \
            __builtin_amdgcn_s_setprio(1); \
            _Pragma("unroll") for (int mt = 0; mt < 4; ++mt) { \
                st[0][mt] = (f32x4){0.f, 0.f, 0.f, 0.f}; st[1][mt] = (f32x4){0.f, 0.f, 0.f, 0.f}; \
                _Pragma("unroll") for (int ks = 0; ks < 2; ++ks) { \
                    const bf16x8 ka = *(const LAS bf16x8*)(kt + ((16 * mt + qi) * KP + sub * 64 + ks * 32 + g4 * 8) * 2); \
                    st[0][mt] = __builtin_amdgcn_mfma_f32_16x16x32_bf16(ka, qf[0][ks], st[0][mt], 0, 0, 0); \
                    st[1][mt] = __builtin_amdgcn_mfma_f32_16x16x32_bf16(ka, qf[1][ks], st[1][mt], 0, 0, 0); \
                } \
            } \
            __builtin_amdgcn_s_setprio(0); \
            bf16x8 pb[2][2]; \
            _Pragma("unroll") for (int rt = 0; rt < 2; ++rt) { \
                const int qrel = q0 + rq + 16 * rt - (kb) * 64;            \
                if (qrel < 63) { \
                    _Pragma("unroll") for (int mt = 0; mt < 4; ++mt) \
                        _Pragma("unroll") for (int i = 0; i < 4; ++i) if (16 * mt + 4 * g4 + i > qrel + qi) st[rt][mt][i] = -1e30f; \
                } \
                float mx = st[rt][0][0]; \
                _Pragma("unroll") for (int mt = 0; mt < 4; ++mt) \
                    _Pragma("unroll") for (int i = 0; i < 4; ++i) mx = fmaxf(mx, st[rt][mt][i]); \
                mx = fmaxf(mx, SHX(mx, x16)); mx = fmaxf(mx, SHX(mx, x32)); \
                const float mnew = fmaxf(mrun[rt], mx); const float alpha = __builtin_amdgcn_exp2f(mrun[rt] - mnew); mrun[rt] = mnew; \
                float ps = 0.f; \
                _Pragma("unroll") for (int mt = 0; mt < 4; ++mt) \
                    _Pragma("unroll") for (int i = 0; i < 4; ++i) { const float e = __builtin_amdgcn_exp2f(st[rt][mt][i] - mnew); st[rt][mt][i] = e; ps += e; } \
                lrun[rt] = lrun[rt] * alpha + ps; \
                if (__builtin_amdgcn_ballot_w64(alpha != 1.0f) != 0ull) { _Pragma("unroll") for (int e = 0; e < 8; ++e) o[rt][e] = o[rt][e] * alpha; } \
                _Pragma("unroll") for (int jp = 0; jp < 2; ++jp) { \
                    u32x4 pw4; pw4.x = cvt_pk_bf16(st[rt][2 * jp][0], st[rt][2 * jp][1]); pw4.y = cvt_pk_bf16(st[rt][2 * jp][2], st[rt][2 * jp][3]); \
                    pw4.z = cvt_pk_bf16(st[rt][2 * jp + 1][0], st[rt][2 * jp + 1][1]); pw4.w = cvt_pk_bf16(st[rt][2 * jp + 1][2], st[rt][2 * jp + 1][3]); \
                    pb[rt][jp] = __builtin_bit_cast(bf16x8, pw4); } \
            } \
            __builtin_amdgcn_s_setprio(1); \
            _Pragma("unroll") for (int jp = 0; jp < 2; ++jp) \
                _Pragma("unroll") for (int e = 0; e < 8; ++e) { \
                    const LAS unsigned char* vp = vt + ((16 * e + qi) * VP + 32 * jp + 4 * g4) * 2; \
                    const u32x2 lo = *(const LAS u32x2*)vp, hi = *(const LAS u32x2*)(vp + 32); \
                    u32x4 va4; va4.x = lo.x; va4.y = lo.y; va4.z = hi.x; va4.w = hi.y; const bf16x8 va = __builtin_bit_cast(bf16x8, va4); \
                    o[0][e] = __builtin_amdgcn_mfma_f32_16x16x32_bf16(va, pb[0][jp], o[0][e], 0, 0, 0); \
                    o[1][e] = __builtin_amdgcn_mfma_f32_16x16x32_bf16(va, pb[1][jp], o[1][e], 0, 0, 0); \
                } \
            __builtin_amdgcn_s_setprio(0); \
        } while (0)
        __syncthreads();
        ATT_LOADR(kreg, vreg, 0); ATT_STORER(kreg, vreg, 0);
        __syncthreads();
        for (int kb = 0; kb <= kl; ++kb) {
            if (kb < kl) ATT_LOADR(kreg, vreg, kb + 1);
            ATT_COMPUTE(kb);
            if (kb < kl) ATT_STORER(kreg, vreg, (kb + 1) & 1);
            __syncthreads();
        }
#undef ATT_LOADR
#undef ATT_STORER
#undef ATT_COMPUTE
        float inv[2];
#pragma unroll
        for (int rt = 0; rt < 2; ++rt) { float lt = lrun[rt]; lt += SHX(lt, x16); lt += SHX(lt, x32); inv[rt] = 1.0f / lt; }
        if (sub == 1) {
#pragma unroll
            for (int rt = 0; rt < 2; ++rt) { LAS float* ox = (LAS float*)lds + ((wave & 3) * 2 + rt) * 2048;
#pragma unroll
                for (int e = 0; e < 8; ++e)
#pragma unroll
                    for (int i = 0; i < 4; ++i) ox[(16 * e + 4 * g4 + i) * 16 + qi] = o[rt][e][i] * inv[rt]; }
        }
        __syncthreads();
        if (sub == 0) {
#pragma unroll
            for (int rt = 0; rt < 2; ++rt) {
                const LAS float* ox = (const LAS float*)lds + ((wave & 3) * 2 + rt) * 2048;
                float ssq = 0.f;
#pragma unroll
                for (int e = 0; e < 8; ++e)
#pragma unroll
                    for (int i = 0; i < 4; ++i) { const float v = o[rt][e][i] * inv[rt] - lam * ox[(16 * e + 4 * g4 + i) * 16 + qi]; o[rt][e][i] = v; ssq += v * v; }
                ssq += SHX(ssq, x16); ssq += SHX(ssq, x32);
                const float rn = rsqrtf(ssq * (1.0f / 128.0f) + 1e-5f);
                bf16_t* yp = YCAT + (size_t)(b * SEQ + q0 + rq + 16 * rt + qi) * DM + 768 + h * 128;
#pragma unroll
                for (int e = 0; e < 8; ++e) {
                    const f32x4 sw = *(const LAS f32x4*)(swl + 16 * e + 4 * g4);
                    u32x2 w; w.x = cvt_pk_bf16(o[rt][e][0] * rn * sw.x, o[rt][e][1] * rn * sw.y); w.y = cvt_pk_bf16(o[rt][e][2] * rn * sw.z, o[rt][e][3] * rn * sw.w);
                    *(u32x2*)(yp + 16 * e + 4 * g4) = w;
                }
            }
        }
    }
}
template <class Epi>
__device__ __forceinline__ void run_gemm(LAS unsigned char* lds, const bf16_t* A, const bf16_t* Bt, int N, int K, const Epi& E) {
    pg8::Gemm g; g.A = A; g.Bt = Bt; g.M = MT; g.N = N; g.K = K;
    pg8::StaticOrder S; S.init(MT, N, gridDim.x, bidx());
    pg8::gemm_phase<Epi, pg8::StaticOrder, true, true>(lds, g, S, E);
}

#ifndef PHASE_MASK
#define PHASE_MASK 0xFFFFu
#endif
constexpr unsigned PHM = PHASE_MASK;
#ifndef DUP_MASK
#define DUP_MASK 0
#endif
constexpr unsigned DUPM = DUP_MASK;
#define PON(k) ((PHM >> (k)) & 1u)
__global__ void __launch_bounds__(512, 2) mk_fwd(Params p) {
    extern __shared__ __attribute__((aligned(16))) unsigned char smem[];
    LAS unsigned char* lds = (LAS unsigned char*)smem;
    cg::grid_group grid = cg::this_grid();
    volatile LAS unsigned* xst = (volatile LAS unsigned*)(lds + 143368);
    if (threadIdx.x == 0) { xst[0] = 0u; xst[1] = 0u;
        __hip_atomic_fetch_add((unsigned*)p.ws + 1536 + ((unsigned)__builtin_amdgcn_s_getreg((3 << 11) | 20) & 0xFu), 1u, __ATOMIC_RELAXED, __HIP_MEMORY_SCOPE_AGENT); }
    __syncthreads();
    unsigned char* ws = p.ws;
    bf16_t* XB = (bf16_t*)(ws + WS_XB); float* RS = (float*)(ws + WS_RS); bf16_t* YCAT = (bf16_t*)(ws + WS_YCAT);
    bf16_t* ACT = (bf16_t*)(ws + WS_ACT); bf16_t* H = (bf16_t*)(ws + WS_H);
    for (int ph = p.ph_lo; ph < p.ph_hi; ++ph) {
        const int s_ = (ph == 0) ? -1 : (ph - 1) % NPL;
        int nrep = 1;
        if (DUPM) { const int kind = (ph == 0) ? 0 : ((s_ == 0 || s_ == 13) ? 1 : ((s_ == 1 || s_ == 14 || s_ == 11 || s_ == 5) ? 2 : ((s_ == 2 || s_ == 12 || s_ == 15) ? 3 : ((s_ == 3) ? 4 : (s_ - 4 + 5)))));
            if ((DUPM >> kind) & 1u) nrep = 2; }
        for (int rep = 0; rep < nrep; ++rep) {
        if (rep) grid.sync();
        const int tid = tidx(), lane = tid & 63, wave = __builtin_amdgcn_readfirstlane(tid >> 6);
        if (ph == 0) { if (PON(0)) prologue(p, lds, wave, lane); }
        else {
            const int l = (ph - 1) / NPL, s = (ph - 1) % NPL;
            if ((s == 0 || s == 13) && PON(1)) {
                EpiGU E; E.ACT = ACT; E.rs = RS;
                run_gemm(lds, XB, (const bf16_t*)(ws + WS_WGU + (size_t)(l * 2 + (s == 13)) * SZ_WGU), 2 * FF, DM, E);
            } else if ((s == 1 || s == 14 || s == 11 || s == 5) && PON(2)) {
                EpiBF E; E.C = (s == 5) ? (bf16_t*)(ws + WS_LR) : H; E.ldc = (s == 5) ? 2304 : DM;
                const bf16_t* Ag = (s == 11) ? YCAT : ((s == 5) ? (const bf16_t*)(ws + WS_LA) : ACT);
                const bf16_t* Bg = (s == 11) ? (const bf16_t*)(ws + WS_WOUT + (size_t)l * SZ_WOUT) : ((s == 5) ? (const bf16_t*)(ws + WS_WLORA + (size_t)l * SZ_WLORA) : (const bf16_t*)(ws + WS_WD + (size_t)(l * 2 + (s == 14)) * SZ_WD));
                run_gemm(lds, Ag, Bg, (s == 5) ? 2304 : DM, (s == 11) ? DM : ((s == 5) ? 256 : FF), E);
                if (s != 5 && gridDim.x == 256) {
                    pg8::StaticOrder S; S.init(MT, DM, 256, bidx()); Unit un; S.next(0, un);
                    const int wh = (s == 1) ? 0 : ((s == 11) ? 1 : 2);
                    unsigned* cnt = (unsigned*)ws + (l * 3 + wh) * 32 + un.pm;
                    __syncthreads();
                    if (tidx() == 0) { __threadfence(); __hip_atomic_fetch_add(cnt, 1u, __ATOMIC_RELAXED, __HIP_MEMORY_SCOPE_AGENT);
                        while (__hip_atomic_load(cnt, __ATOMIC_RELAXED, __HIP_MEMORY_SCOPE_AGENT) < 8u) __builtin_amdgcn_s_sleep(2);
                        __threadfence(); }
                    __syncthreads();
                    const int tid2 = tidx(), lane2 = tid2 & 63, wave2 = __builtin_amdgcn_readfirstlane(tid2 >> 6);
                    const float* g = p.in[s == 1 ? 4 : (s == 11 ? 34 : 38)] + l * DM;
                    row_phase(H, nullptr, (ph == NPH - 2) ? p.out : nullptr, XB, RS, g, s == 11 ? 1.0f : 0.5f, wave2, lane2, un.pm * 256 + un.pn * 32, 32);
                }
            } else if ((s == 2 || s == 12 || s == 15) && PON(3) && gridDim.x != 256) {
                const float* g = p.in[s == 2 ? 4 : (s == 12 ? 34 : 38)] + l * DM;
                row_phase(H, nullptr, (ph == NPH - 1) ? p.out : nullptr, XB, RS, g, s == 12 ? 1.0f : 0.5f, wave, lane);
            } else if (s == 3 && PON(4)) {
                EpiIN E; E.ZR = (float*)(ws + WS_ZR); E.DAQK = (bf16_t*)(ws + WS_DAQK); E.VT = (bf16_t*)(ws + WS_VT); E.ZS = (float*)(ws + WS_ZS); E.rs = RS;
                run_gemm(lds, XB, (const bf16_t*)(ws + WS_WIN + (size_t)l * SZ_WIN), INC, DM, E);
            } else if (s == 4 && PON(5)) {
                la_prep(p, l);
                s5_scan<1>(p, l, wave - 4, 4, bidx(), gridDim.x, lane, lds);
            } else if (s == 6 && PON(7)) {
                rwkv_scan<1>(p, l, wave, lane, lds);
                s5_scan<2>(p, l, (wave == 3) ? 0 : ((wave == 7) ? 1 : -1), 2, bidx(), gridDim.x, lane, lds + 24576);
            } else if ((s == 7 || s == 9) && PON(8)) {
                const int tid_ = tidx(), lane = tid_ & 63, wave = __builtin_amdgcn_readfirstlane(tid_ >> 6);
                const int G = gridDim.x; bool do_attn = true;
                if (s == 7) {
                    if (G >= 48) {
                        if (bidx() < 24) { rwkv_combine(p, bidx(), wave, lane, lds);
                            __syncthreads(); if (tidx() == 0) __hip_atomic_fetch_add((unsigned*)ws + 264 + l, 1u, __ATOMIC_RELAXED, __HIP_MEMORY_SCOPE_AGENT);
                            do_attn = false; }
                        else if (l == 0) { for (int gt = 2536 + bidx() - 24; gt < 2536 + 1376; gt += G - 24) weight_tile(p, gt, lds); }
                    } else {
                        for (int bh = bidx(); bh < 24; bh += G) rwkv_combine(p, bh, wave, lane, lds);
                        if (l == 0) { __syncthreads(); for (int gt = 2536 + bidx(); gt < 2536 + 1376; gt += G) weight_tile(p, gt, lds); }
                        do_attn = false;
                    }
                } else {
                    EpiGLU E; E.YCAT = YCAT; E.YS = (const float*)(ws + WS_YS); E.bglu = p.in[32] + l * 512;
                    run_gemm(lds, (const bf16_t*)(ws + WS_YSB), (const bf16_t*)(ws + WS_WGLU + (size_t)l * SZ_WGLU), 512, 512, E);
                }
                if (do_attn && PON(11)) attn_phase(p, l, wave, lane, lds, s == 7);
            } else if (s == 8 && PON(9)) {
                rwkv_out(p, l, wave, lane, lds);
            }
        }
        }
        { const int sx = (ph > 0) ? (ph - 1) % NPL : -1; const bool skip = (sx == 10) || (gridDim.x == 256 && (sx == 2 || sx == 12 || sx == 15));
          if (ph + 1 < p.ph_hi && !skip) {
              if (ph == p.ph_lo) grid.sync();
              else {
                  asm volatile("s_waitcnt vmcnt(0)" ::: "memory");
                  __syncthreads();
                  if (threadIdx.x == 0) {
                      unsigned* wsw = (unsigned*)p.ws; unsigned* base = wsw + 16384 + ph * 4096;
                      const unsigned xcc = (unsigned)__builtin_amdgcn_s_getreg((3 << 11) | 20) & 0xFu;
                      unsigned nloc = xst[0], nx = xst[1];
                      if (nloc == 0u) {
                          nx = 0u;
#pragma unroll
                          for (unsigned j = 0; j < 16; ++j) { const unsigned cj = __hip_atomic_load(wsw + 1536 + j, __ATOMIC_RELAXED, __HIP_MEMORY_SCOPE_AGENT); nx += (cj > 0u) ? 1u : 0u; nloc = (j == xcc) ? cj : nloc; }
                          xst[0] = nloc; xst[1] = nx;
                      }
                      const unsigned old = __hip_atomic_fetch_add(base + xcc * 64, 1u, __ATOMIC_RELAXED, __HIP_MEMORY_SCOPE_AGENT);
                      if (old + 1u == nloc) {
                          __builtin_amdgcn_fence(__ATOMIC_RELEASE, "agent");
                          asm volatile("s_waitcnt vmcnt(0)" ::: "memory");
                          const unsigned ot = __hip_atomic_fetch_add(base + 2048, 1u, __ATOMIC_RELAXED, __HIP_MEMORY_SCOPE_AGENT);
                          if (ot + 1u != nx) while (__hip_atomic_load(base + 2048, __ATOMIC_RELAXED, __HIP_MEMORY_SCOPE_AGENT) < nx) __builtin_amdgcn_s_sleep(1);
                          __builtin_amdgcn_fence(__ATOMIC_ACQUIRE, "agent");
                          __hip_atomic_fetch_add(base + 1024 + xcc * 64, 1u, __ATOMIC_RELAXED, __HIP_MEMORY_SCOPE_AGENT);
                          asm volatile("s_waitcnt vmcnt(0)" ::: "memory");
                      } else {
                          while (__hip_atomic_load(base + 1024 + xcc * 64, __ATOMIC_RELAXED, __HIP_MEMORY_SCOPE_AGENT) == 0u) __builtin_amdgcn_s_sleep(1);
                          __builtin_amdgcn_fence(__ATOMIC_ACQUIRE, "agent");
                          asm volatile("s_waitcnt vmcnt(0)" ::: "memory");
                      }
                  }
                  __syncthreads();
              }
          } }
    }
}

extern "C" void kernel_launch(void* const* d_in, const int* in_sizes, int n_in, void* d_out, int out_size, void* d_ws, size_t ws_size, hipStream_t stream) {
    static int grid = 0;
    if (grid == 0) {
        if (n_in != 39 || out_size != MT * DM || ws_size < WS_END) { fprintf(stderr, "kernel_launch: unexpected sizes: n_in %d out %d ws %zu (need %zu)\n", n_in, out_size, ws_size, (size_t)WS_END); grid = -1; return; }
        int dev = 0, cus = 0, per_cu = 0;
        hipGetDevice(&dev); hipDeviceGetAttribute(&cus, hipDeviceAttributeMultiprocessorCount, dev);
        if (hipFuncSetAttribute((const void*)mk_fwd, hipFuncAttributeMaxDynamicSharedMemorySize, LDS_BYTES) != hipSuccess) { fprintf(stderr, "kernel_launch: hipFuncSetAttribute failed\n"); grid = -1; return; }
        if (hipOccupancyMaxActiveBlocksPerMultiprocessor(&per_cu, (const void*)mk_fwd, 512, LDS_BYTES) != hipSuccess || per_cu < 1) { fprintf(stderr, "kernel_launch: occupancy query gives %d\n", per_cu); per_cu = 1; }
        (void)hipGetLastError();
        grid = cus * 1;
        fprintf(stderr, "kernel_launch: cus %d per_cu %d grid %d\n", cus, per_cu, grid);
    }
    if (grid < 0) return;
    if (hipMemsetAsync(d_ws, 0, 1u << 20, stream) != hipSuccess) { fprintf(stderr, "kernel_launch: hipMemsetAsync failed\n"); return; }
    Params a{};
    for (int i = 0; i < 39; ++i) a.in[i] = (const float*)d_in[i];
    a.out = (float*)d_out; a.ws = (unsigned char*)d_ws;
#if ONE_LAUNCH
    a.ph_lo = 0; a.ph_hi = NPH;
    void* args[] = {&a};
    hipError_t e = hipLaunchCooperativeKernel((const void*)mk_fwd, dim3(grid), dim3(512), args, LDS_BYTES, stream);
    if (e != hipSuccess) fprintf(stderr, "cooperative launch failed: %s (grid %d)\n", hipGetErrorString(e), grid);
#else
    for (int ph = 0; ph < NPH; ++ph) {
        a.ph_lo = ph; a.ph_hi = ph + 1;
        hipLaunchKernelGGL(mk_fwd, dim3(grid), dim3(512), LDS_BYTES, stream, a);
    }
#endif
}
```

```cpp
#include <hip/hip_runtime.h>
#include <hip/hip_cooperative_groups.h>
#include <cstdio>
#include <cstdint>
namespace cg = cooperative_groups;
#ifndef ONE_LAUNCH
#define ONE_LAUNCH 1
#endif
__device__ __forceinline__ int tidx() { int t = threadIdx.x; asm volatile("" : "+v"(t)); return t; }
__device__ __forceinline__ int bidx() { int b = blockIdx.x; asm volatile("" : "+s"(b)); return b; }
namespace pg8 {
#define PG8_LAS __attribute__((address_space(3)))
typedef unsigned short bf16_t;
typedef short bf16x8 __attribute__((ext_vector_type(8)));
typedef float f32x4 __attribute__((ext_vector_type(4)));
typedef unsigned u32x4 __attribute__((ext_vector_type(4)));
constexpr int BM = 256, BK = 64, HALF = 128, HTB = HALF * BK * 2  , STAGE_BYTES = 8 * HTB, NXCD = 8, WGM = 8;

__host__ __device__ __forceinline__ int lds_byte(int r, int c) { const int st = (r >> 4) * 2 + (c >> 5), rr = r & 15, cc = c & 31, ob = rr * 64 + cc * 2; return st * 1024 + (ob ^ (((ob >> 9) & 1) << 5)); }
__host__ __device__ __forceinline__ void stage_rc(int b, int& R, int& C) { const int st = b / 1024, sb = b % 1024, swz = sb ^ (((sb >> 9) & 1) << 5); R = (st >> 1) * 16 + swz / 64; C = (st & 1) * 32 + (swz % 64) / 2; }
__host__ __device__ __forceinline__ int perm32(int rho) { const int n = rho >> 4, i = rho & 15; return 8 * (i >> 2) + 4 * n + (i & 3); }

struct Unit { int pm, pn; };
struct Gemm { const bf16_t* A; const bf16_t* Bt; int M, N, K; };

struct StaticOrder {
    int nM, nN, nwg, G, c;
    __host__ __device__ void init(int M, int N, int G_, int c_) { nM = M / BM; nN = N / BM; nwg = nM * nN; G = G_; c = c_; }
    __host__ __device__ bool next(int i, Unit& u) const {
        const long L = (long)i * G + c; if (L >= nwg) return false;
        int wgid = (int)L; { const int q = nwg / NXCD, r = nwg % NXCD, xcd = wgid % NXCD, off = wgid / NXCD; wgid = (xcd < r ? xcd * (q + 1) : r * (q + 1) + (xcd - r) * q) + off; }
        const int wgm = (nN == 8) ? 4 : WGM;
        const int nig = wgm * nN, gid = wgid / nig, fm = gid * wgm, gsz = (nM - fm) < wgm ? (nM - fm) : wgm;
        u.pm = fm + ((wgid % nig) % gsz); u.pn = (wgid % nig) / gsz; return true;
    }
    __device__ __forceinline__ void a_ready(const Unit&) const {}
    __device__ __forceinline__ void done(const Unit&) const {}
};

__device__ __forceinline__ unsigned cvt_pk_bf16(float lo, float hi) { unsigned r; asm volatile("v_cvt_pk_bf16_f32 %0, %1, %2" : "=v"(r) : "v"(lo), "v"(hi)); return r; }
typedef float f32x2 __attribute__((ext_vector_type(2)));

template <class Epi, class Sched, bool ALIGN_EPI = false, bool SP2 = false>
__device__ __forceinline__ void gemm_phase(PG8_LAS unsigned char* lds, const Gemm g, const Sched& S, const Epi& E) {
    const int tid = tidx(), wid = __builtin_amdgcn_readfirstlane(tid >> 6), lane = tid & 63, wr = wid >> 2, wc = wid & 3, fr = lane & 15, fq = lane >> 4;
    const int K = g.K, nt = K / BK;
    unsigned voffA[2], voffB[2];
#pragma unroll
    for (int i = 0; i < 2; ++i) { int R, C; stage_rc(tid * 16 + i * 8192, R, C); const int Rb = Epi::PERM ? ((R & ~31) + perm32(R & 31)) : R;
        voffA[i] = (unsigned)(R * K + C) * 2u; voffB[i] = (unsigned)(Rb * K + C) * 2u; }
    const size_t kstep = (size_t)(BK * 2);
    const size_t hstep = (size_t)HALF * K * 2;
    const size_t tstep = 2 * hstep;
    const unsigned ldsw = (unsigned)wid * 1024u;
    const int aoff = lds_byte(wr * 64 + fr, fq * 8), boff = lds_byte(wc * 32 + fr, fq * 8);
#define PG8_SA(b, h) (((b) * 2 + (h)) * HTB)
#define PG8_SB(b, h) ((4 + (b) * 2 + (h)) * HTB)
#define PG8_STAGE(bufoff, gbase, voff) do { _Pragma("unroll") for (int _i = 0; _i < 2; ++_i) \
        __builtin_amdgcn_global_load_lds((const unsigned*)((const char*)(gbase) + (voff)[_i]), (PG8_LAS unsigned*)(lds + (bufoff) + ldsw + _i * 8192), 16, 0, 0); } while (0)
#define PG8_LDA(dst, b, h) do { _Pragma("unroll") for (int m = 0; m < 4; ++m) _Pragma("unroll") for (int k = 0; k < 2; ++k) dst[m][k] = *(const PG8_LAS bf16x8*)(lds + PG8_SA(b, h) + aoff + m * 2048 + k * 1024); } while (0)
#define PG8_LDB(dst, b, h) do { _Pragma("unroll") for (int n = 0; n < 2; ++n) _Pragma("unroll") for (int k = 0; k < 2; ++k) dst[n][k] = *(const PG8_LAS bf16x8*)(lds + PG8_SB(b, h) + boff + n * 2048 + k * 1024); } while (0)
#define PG8_MMA(ai, bj, At, Bt) do { __builtin_amdgcn_s_setprio(1); _Pragma("unroll") for (int m = 0; m < 4; ++m) _Pragma("unroll") for (int n = 0; n < 2; ++n) _Pragma("unroll") for (int k = 0; k < 2; ++k) \
        acc[ai][bj][m][n] = __builtin_amdgcn_mfma_f32_16x16x32_bf16(Bt[n][k], At[m][k], acc[ai][bj][m][n], 0, 0, 0); __builtin_amdgcn_s_setprio(0); } while (0)
#define PG8_WAIT_V(n) asm volatile("s_waitcnt vmcnt(" #n ")" ::: "memory")
#define PG8_WAIT_L(n) asm volatile("s_waitcnt lgkmcnt(" #n ")" ::: "memory")
#define PG8_BAR __builtin_amdgcn_s_barrier()
#define PG8_SCHED __builtin_amdgcn_sched_barrier(0)
    Unit cur, nxt; int ui = 0;
    if (!S.next(0, cur)) return;
    f32x4 acc[2][2][4][2];
#pragma unroll
    for (int a = 0; a < 2; ++a)
#pragma unroll
        for (int b = 0; b < 2; ++b)
#pragma unroll
            for (int m = 0; m < 4; ++m)
#pragma unroll
                for (int n = 0; n < 2; ++n) acc[a][b][m][n] = (f32x4){0.f, 0.f, 0.f, 0.f};
    bf16x8 At[4][2], B0[2][2], B1[2][2];
    const char* cA = (const char*)g.A + (size_t)cur.pm * tstep; const char* cB = (const char*)g.Bt + (size_t)cur.pn * tstep;
    S.a_ready(cur);
    if constexpr (SP2) {
        PG8_STAGE(PG8_SB(0, 0), cB, voffB); PG8_STAGE(PG8_SB(0, 1), cB + hstep, voffB); PG8_STAGE(PG8_SA(0, 0), cA, voffA); PG8_STAGE(PG8_SA(0, 1), cA + hstep, voffA);
        if (wr == 1) PG8_BAR;
        PG8_WAIT_V(2); PG8_BAR;
        PG8_STAGE(PG8_SB(1, 0), cB + kstep, voffB); PG8_STAGE(PG8_SA(1, 0), cA + kstep, voffA); PG8_STAGE(PG8_SB(1, 1), cB + hstep + kstep, voffB);
        PG8_WAIT_V(6); PG8_BAR;
    } else {
        PG8_STAGE(PG8_SB(0, 0), cB, voffB); PG8_STAGE(PG8_SA(0, 0), cA, voffA); PG8_STAGE(PG8_SB(0, 1), cB + hstep, voffB); PG8_STAGE(PG8_SA(0, 1), cA + hstep, voffA);
        if (wr == 1) PG8_BAR;
        PG8_WAIT_V(4); PG8_BAR;
        PG8_STAGE(PG8_SB(1, 0), cB + kstep, voffB); PG8_STAGE(PG8_SA(1, 0), cA + kstep, voffA); PG8_STAGE(PG8_SB(1, 1), cB + hstep + kstep, voffB);
        PG8_WAIT_V(6); PG8_BAR;
    }
    for (;;) {
        const bool has_next = S.next(ui + 1, nxt);
        const char* nA = has_next ? (const char*)g.A + (size_t)nxt.pm * tstep : cA; const char* nB = has_next ? (const char*)g.Bt + (size_t)nxt.pn * tstep : cB;
        for (int t = 0; t < nt; t += 2) {
            const bool last = (t == nt - 2);
            const char* a1 = cA + (size_t)(t + 1) * kstep;
            const char* a2 = last ? nA : cA + (size_t)(t + 2) * kstep; const char* b2 = last ? nB : cB + (size_t)(t + 2) * kstep;
            const char* a3 = a2 + kstep; const char* b3 = b2 + kstep;
            if (last && has_next) S.a_ready(nxt);
            if constexpr (SP2) {
            PG8_LDB(B0, 0, 0); PG8_LDB(B1, 0, 1); PG8_SCHED; PG8_LDA(At, 0, 0); PG8_STAGE(PG8_SA(1, 1), a1 + hstep, voffA);
            PG8_WAIT_V(8); PG8_WAIT_L(0); PG8_BAR; PG8_MMA(0, 0, At, B0); PG8_MMA(0, 1, At, B1); PG8_BAR; PG8_SCHED;
            PG8_LDA(At, 0, 1); PG8_STAGE(PG8_SB(0, 0), b2, voffB); PG8_STAGE(PG8_SB(0, 1), b2 + hstep, voffB); PG8_STAGE(PG8_SA(0, 0), a2, voffA);
            PG8_WAIT_V(8); PG8_WAIT_L(0); PG8_BAR; PG8_MMA(1, 0, At, B0); PG8_MMA(1, 1, At, B1); PG8_BAR; PG8_SCHED;
            PG8_LDB(B0, 1, 0); PG8_LDB(B1, 1, 1); PG8_SCHED; PG8_LDA(At, 1, 0); PG8_STAGE(PG8_SA(0, 1), a2 + hstep, voffA);
            PG8_WAIT_V(8); PG8_WAIT_L(0); PG8_BAR; PG8_MMA(0, 0, At, B0); PG8_MMA(0, 1, At, B1); PG8_BAR; PG8_SCHED;
            PG8_LDA(At, 1, 1); PG8_STAGE(PG8_SB(1, 0), b3, voffB); PG8_STAGE(PG8_SB(1, 1), b3 + hstep, voffB); PG8_STAGE(PG8_SA(1, 0), a3, voffA);
            PG8_WAIT_V(8); PG8_WAIT_L(0); PG8_BAR; PG8_MMA(1, 0, At, B0); PG8_MMA(1, 1, At, B1); PG8_BAR; PG8_SCHED;
            } else {
            PG8_LDB(B0, 0, 0); PG8_SCHED; PG8_LDA(At, 0, 0); PG8_STAGE(PG8_SA(1, 1), a1 + hstep, voffA);
            PG8_WAIT_L(8); PG8_BAR; PG8_WAIT_L(0); PG8_MMA(0, 0, At, B0); PG8_BAR; PG8_SCHED;
            PG8_LDB(B1, 0, 1); PG8_STAGE(PG8_SB(0, 0), b2, voffB);
            PG8_BAR; PG8_WAIT_L(0); PG8_MMA(0, 1, At, B1); PG8_BAR;
            PG8_LDA(At, 0, 1); PG8_STAGE(PG8_SA(0, 0), a2, voffA);
            PG8_BAR; PG8_WAIT_L(0); PG8_MMA(1, 0, At, B0); PG8_BAR; PG8_SCHED;
            PG8_STAGE(PG8_SB(0, 1), b2 + hstep, voffB);
            PG8_WAIT_V(6); PG8_BAR; PG8_MMA(1, 1, At, B1); PG8_BAR;
            PG8_LDB(B0, 1, 0); PG8_SCHED; PG8_LDA(At, 1, 0); PG8_STAGE(PG8_SA(0, 1), a2 + hstep, voffA);
            PG8_WAIT_L(8); PG8_BAR; PG8_WAIT_L(0); PG8_MMA(0, 0, At, B0); PG8_BAR; PG8_SCHED;
            PG8_LDB(B1, 1, 1); PG8_STAGE(PG8_SB(1, 0), b3, voffB);
            PG8_BAR; PG8_WAIT_L(0); PG8_MMA(0, 1, At, B1); PG8_BAR;
            PG8_LDA(At, 1, 1); PG8_STAGE(PG8_SA(1, 0), a3, voffA);
            PG8_BAR; PG8_WAIT_L(0); PG8_MMA(1, 0, At, B0); PG8_BAR; PG8_SCHED;
            PG8_STAGE(PG8_SB(1, 1), b3 + hstep, voffB);
            PG8_WAIT_V(6); PG8_BAR; PG8_MMA(1, 1, At, B1); PG8_BAR;
            }
        }
        if constexpr (ALIGN_EPI) { if (wr == 0) PG8_BAR; }
        if constexpr (!Epi::AFTER_DRAIN) { E(acc, cur, wr, wc, fr, fq); S.done(cur); }
        if (!has_next) break;
#pragma unroll
        for (int a = 0; a < 2; ++a)
#pragma unroll
            for (int b = 0; b < 2; ++b)
#pragma unroll
                for (int m = 0; m < 4; ++m)
#pragma unroll
                    for (int n = 0; n < 2; ++n) acc[a][b][m][n] = (f32x4){0.f, 0.f, 0.f, 0.f};
        cur = nxt; cA = nA; cB = nB; ++ui;
        if constexpr (ALIGN_EPI) { if (wr == 1) PG8_BAR; }
    }
    PG8_WAIT_V(0);
    if constexpr (!ALIGN_EPI) { if (wr == 0) PG8_BAR; }
    PG8_BAR;
    if constexpr (Epi::AFTER_DRAIN) { E.fused(acc, cur, wr, wc, fr, fq, lds, wid, lane); S.done(cur); }
#undef PG8_SA
#undef PG8_SB
#undef PG8_STAGE
#undef PG8_LDA
#undef PG8_LDB
#undef PG8_MMA
#undef PG8_WAIT_V
#undef PG8_WAIT_L
#undef PG8_BAR
#undef PG8_SCHED
}
}
using pg8::bf16_t; using pg8::bf16x8; using pg8::f32x4; using pg8::u32x4; using pg8::Unit; using pg8::cvt_pk_bf16;
#define LAS __attribute__((address_space(3)))
typedef float f32x2 __attribute__((ext_vector_type(2)));
typedef unsigned u32x2 __attribute__((ext_vector_type(2)));
typedef short bf16x4 __attribute__((ext_vector_type(4)));
#define WAVE_SYNC() asm volatile("s_waitcnt lgkmcnt(0)" ::: "memory")

constexpr int MT = 8192, SEQ = 4096, DM = 2048, FF = 5504, INC = 5376, RWC = 2560;
constexpr int NPL = 16, NPH = 1 + 2 * NPL;
constexpr int LDS_BYTES = 147456;
constexpr size_t MiB = 1u << 20;
constexpr size_t SZ_WGU = (size_t)11008 * 2048 * 2, SZ_WD = (size_t)2048 * 5504 * 2, SZ_WIN = (size_t)5376 * 2048 * 2, SZ_WOUT = (size_t)2048 * 2048 * 2;
constexpr size_t SZ_WLORA = (size_t)2304 * 256 * 2, SZ_WGLU = (size_t)512 * 512 * 2, SZ_S5TAB = (size_t)(32 * 64 * 2 + 32 * 64 * 32) * 4;
constexpr size_t WS_WGU = 1 * MiB;
constexpr size_t WS_WD = WS_WGU + 4 * SZ_WGU;
constexpr size_t WS_WIN = WS_WD + 4 * SZ_WD;
constexpr size_t WS_WOUT = WS_WIN + 2 * SZ_WIN;
constexpr size_t WS_WLORA = WS_WOUT + 2 * SZ_WOUT;
constexpr size_t WS_WGLU = WS_WLORA + 2 * SZ_WLORA;
constexpr size_t WS_S5TAB = WS_WGLU + 2 * SZ_WGLU;
constexpr size_t WS_XB = ((WS_S5TAB + 2 * SZ_S5TAB + MiB - 1) / MiB) * MiB;
constexpr size_t WS_RS = WS_XB + 32 * MiB;
constexpr size_t WS_YCAT = WS_RS + 1 * MiB;
constexpr size_t WS_BIG = WS_YCAT + 32 * MiB;
constexpr size_t WS_ACT = WS_BIG, WS_H = WS_BIG + 96 * MiB;
constexpr size_t WS_ZR = WS_BIG, WS_DAQK = WS_BIG + 80 * MiB, WS_VT = WS_BIG + 104 * MiB, WS_ZS = WS_BIG + 116 * MiB, WS_LA = WS_BIG + 132 * MiB;
constexpr size_t WS_LR = WS_BIG + 136 * MiB, WS_SEND = WS_BIG + 208 * MiB, WS_SIN = WS_BIG + 232 * MiB;
constexpr size_t WS_YS = WS_BIG + 244 * MiB, WS_YSB = WS_BIG + 260 * MiB, WS_XE = WS_BIG + 268 * MiB, WS_XIN = WS_BIG + 269 * MiB;
constexpr size_t WS_YL = WS_BIG + 172 * MiB, WS_BON = WS_BIG + 196 * MiB, WS_QQ = WS_BIG + 270 * MiB, WS_END = WS_BIG + 294 * MiB;
static_assert(WS_END <= 700 * MiB, "workspace budget");

struct Params { const float* in[39]; float* out; unsigned char* ws; int ph_lo, ph_hi; };

#define DPPF(v, ctrl) __builtin_bit_cast(float, __builtin_amdgcn_mov_dpp(__builtin_bit_cast(int, (v)), (ctrl), 0xf, 0xf, true))
__device__ __forceinline__ float wave_sum(float v) {
    v += DPPF(v, 0xB1); v += DPPF(v, 0x4E); v += DPPF(v, 0x124); v += DPPF(v, 0x128);
    const float r0 = __builtin_bit_cast(float, __builtin_amdgcn_readlane(__builtin_bit_cast(int, v), 0)), r1 = __builtin_bit_cast(float, __builtin_amdgcn_readlane(__builtin_bit_cast(int, v), 16));
    const float r2 = __builtin_bit_cast(float, __builtin_amdgcn_readlane(__builtin_bit_cast(int, v), 32)), r3 = __builtin_bit_cast(float, __builtin_amdgcn_readlane(__builtin_bit_cast(int, v), 48));
    return (r0 + r1) + (r2 + r3);
}
__device__ __forceinline__ float sigmoidf_(float x) { return __builtin_amdgcn_rcpf(1.0f + __expf(-x)); }
__device__ __forceinline__ float dot4(f32x4 a, f32x4 b) { return (a.x * b.x + a.y * b.y) + (a.z * b.z + a.w * b.w); }

struct EpiGU {
    static constexpr bool PERM = true, AFTER_DRAIN = false;
    bf16_t* ACT; const float* rs;
    __device__ __forceinline__ void operator()(const f32x4 (&acc)[2][2][4][2], const Unit& u, int wr, int wc, int fr, int fq) const {
        const int row0 = u.pm * 256 + wr * 64 + fr, col0 = u.pn * 128 + wc * 32 + fq * 8;
        float sv[2][4];
#pragma unroll
        for (int ai = 0; ai < 2; ++ai)
#pragma unroll
            for (int m = 0; m < 4; ++m) sv[ai][m] = rs[row0 + ai * 128 + m * 16];
#pragma unroll
        for (int ai = 0; ai < 2; ++ai)
#pragma unroll
            for (int m = 0; m < 4; ++m) {
                const int row = row0 + ai * 128 + m * 16; const float s = sv[ai][m];
                float o[8];
#pragma unroll
                for (int n = 0; n < 2; ++n)
#pragma unroll
                    for (int j = 0; j < 4; ++j) { const float g = acc[ai][0][m][n][j] * s, up = acc[ai][1][m][n][j] * s; o[n * 4 + j] = g * sigmoidf_(g) * up; }
                u32x4 w; w.x = cvt_pk_bf16(o[0], o[1]); w.y = cvt_pk_bf16(o[2], o[3]); w.z = cvt_pk_bf16(o[4], o[5]); w.w = cvt_pk_bf16(o[6], o[7]);
                *(u32x4*)(ACT + (size_t)row * FF + col0) = w;
            }
    }
};
#define BF2F(x) __builtin_bit_cast(float, ((unsigned)(x)) << 16)
struct EpiBF {
    static constexpr bool PERM = true, AFTER_DRAIN = false;
    bf16_t* C; int ldc;
    __device__ __forceinline__ void operator()(const f32x4 (&acc)[2][2][4][2], const Unit& u, int wr, int wc, int fr, int fq) const {
        const int row0 = u.pm * 256 + wr * 64 + fr, col0 = u.pn * 256 + wc * 32 + fq * 8;
#pragma unroll
        for (int ai = 0; ai < 2; ++ai)
#pragma unroll
            for (int m = 0; m < 4; ++m)
#pragma unroll
                for (int bj = 0; bj < 2; ++bj) {
                    const f32x4 v0 = acc[ai][bj][m][0], v1 = acc[ai][bj][m][1];
                    u32x4 w; w.x = cvt_pk_bf16(v0[0], v0[1]); w.y = cvt_pk_bf16(v0[2], v0[3]); w.z = cvt_pk_bf16(v1[0], v1[1]); w.w = cvt_pk_bf16(v1[2], v1[3]);
                    *(u32x4*)(C + (size_t)(row0 + ai * 128 + m * 16) * ldc + col0 + bj * 128) = w;
                }
    }
};
struct EpiIN {
    static constexpr bool PERM = true, AFTER_DRAIN = false;
    float* ZR; bf16_t* DAQK; bf16_t* VT; float* ZS; const float* rs;
    __device__ __forceinline__ void operator()(const f32x4 (&acc)[2][2][4][2], const Unit& u, int wr, int wc, int fr, int fq) const {
        const int row0 = u.pm * 256 + wr * 64 + fr, cl0 = wc * 32 + fq * 8; const int pn = u.pn;
        float sv[2][4];
#pragma unroll
        for (int ai = 0; ai < 2; ++ai)
#pragma unroll
            for (int m = 0; m < 4; ++m) sv[ai][m] = rs[row0 + ai * 128 + m * 16];
#pragma unroll
        for (int ai = 0; ai < 2; ++ai)
#pragma unroll
            for (int m = 0; m < 4; ++m) {
                const int row = row0 + ai * 128 + m * 16; const float s = sv[ai][m];
#pragma unroll
                for (int bj = 0; bj < 2; ++bj) {
                    const f32x4 v0 = acc[ai][bj][m][0] * s, v1 = acc[ai][bj][m][1] * s; const int cl = cl0 + bj * 128;
                    if (pn < 10) { float* p = ZR + (size_t)row * RWC + pn * 256 + cl; *(f32x4*)p = v0; *(f32x4*)(p + 4) = v1; }
                    else if (pn < 16) { const float sc = (pn < 13) ? 0.18033688011112042f : 1.0f;
                        u32x4 w; w.x = cvt_pk_bf16(v0[0] * sc, v0[1] * sc); w.y = cvt_pk_bf16(v0[2] * sc, v0[3] * sc); w.z = cvt_pk_bf16(v1[0] * sc, v1[1] * sc); w.w = cvt_pk_bf16(v1[2] * sc, v1[3] * sc);
                        *(u32x4*)(DAQK + (size_t)row * 1536 + (pn - 10) * 256 + cl) = w; }
                    else if (pn < 19) { const int b = row >> 12, t = row & 4095; bf16_t* p = VT + ((size_t)(b * 768 + (pn - 16) * 256 + cl)) * SEQ + t;
#pragma unroll
                        for (int j = 0; j < 4; ++j) { p[(size_t)j * SEQ] = (bf16_t)(cvt_pk_bf16(v0[j], 0.f) & 0xffffu); p[(size_t)(j + 4) * SEQ] = (bf16_t)(cvt_pk_bf16(v1[j], 0.f) & 0xffffu); } }
                    else { float* p = ZS + (size_t)row * 512 + (pn - 19) * 256 + cl; *(f32x4*)p = v0; *(f32x4*)(p + 4) = v1; }
                }
            }
    }
};
__device__ __forceinline__ float decay_of(float x) {
    return __expf(-0.6065306597126334f * sigmoidf_(x));
}
struct EpiGLU {
    static constexpr bool PERM = true, AFTER_DRAIN = false;
    bf16_t* YCAT; const float* YS; const float* bglu;
    __device__ __forceinline__ void operator()(const f32x4 (&acc)[2][2][4][2], const Unit& u, int wr, int wc, int fr, int fq) const {
        const int row0 = u.pm * 256 + wr * 64 + fr, col0 = u.pn * 256 + wc * 32 + fq * 8;
#pragma unroll
        for (int bj = 0; bj < 2; ++bj) {
            const int c = col0 + bj * 128;
            const f32x4 b0 = *(const f32x4*)(bglu + c), b1 = *(const f32x4*)(bglu + c + 4);
#pragma unroll
            for (int ai = 0; ai < 2; ++ai)
#pragma unroll
                for (int m = 0; m < 4; ++m) {
                    const int row = row0 + ai * 128 + m * 16;
                    const f32x4 y0 = *(const f32x4*)(YS + (size_t)row * 512 + c), y1 = *(const f32x4*)(YS + (size_t)row * 512 + c + 4);
                    const f32x4 a0 = acc[ai][bj][m][0] + b0, a1 = acc[ai][bj][m][1] + b1;
                    float o[8];
#pragma unroll
                    for (int j = 0; j < 4; ++j) { o[j] = y0[j] * sigmoidf_(a0[j]); o[4 + j] = y1[j] * sigmoidf_(a1[j]); }
                    u32x4 w; w.x = cvt_pk_bf16(o[0], o[1]); w.y = cvt_pk_bf16(o[2], o[3]); w.z = cvt_pk_bf16(o[4], o[5]); w.w = cvt_pk_bf16(o[6], o[7]);
                    *(u32x4*)(YCAT + (size_t)row * DM + 1536 + c) = w;
                }
        }
    }
};
__device__ __forceinline__ void transpose_tile(const float* src, int ld, int K, const float* gvec, bf16_t* dst, int kt, int nt, int mode, LAS float* tl) {
    const int tid = tidx(); const int k0 = kt * 128, n0 = nt * 256;
    f32x4 v[16];
    const int j = (tid & 63) * 4; const int sc = (mode == 1) ? ((j < 128) ? nt * 128 + j : FF + nt * 128 + j - 128) : n0 + j;
    const float* sp = src + (size_t)(k0 + (tid >> 6)) * ld + sc;
#pragma unroll
    for (int i = 0; i < 16; ++i) v[i] = *(const f32x4*)(sp + (size_t)(8 * i) * ld);
#pragma unroll
    for (int i = 0; i < 16; ++i) {
        const int row = (tid >> 6) + 8 * i;
        const float g = gvec ? gvec[k0 + row] : 1.f;
        const int sw = ((row >> 3) & 15) << 1; LAS float* q = tl + row * 256;
        q[(j) ^ sw] = v[i].x * g; q[(j + 1) ^ sw] = v[i].y * g; q[(j + 2) ^ sw] = v[i].z * g; q[(j + 3) ^ sw] = v[i].w * g;
    }
    __syncthreads();
#pragma unroll
    for (int jj = 0; jj < 8; ++jj) {
        const int c = tid + 512 * jj; const int n = c >> 4, kc = c & 15;
        float x[8];
#pragma unroll
        for (int i = 0; i < 8; ++i) x[i] = tl[(kc * 8 + i) * 256 + (n ^ (kc << 1))];
        u32x4 w; w.x = cvt_pk_bf16(x[0], x[1]); w.y = cvt_pk_bf16(x[2], x[3]); w.z = cvt_pk_bf16(x[4], x[5]); w.w = cvt_pk_bf16(x[6], x[7]);
        *(u32x4*)(dst + (size_t)(n0 + n) * K + k0 + kc * 8) = w;
    }
    __syncthreads();
}

__device__ __forceinline__ void row_phase(const bf16_t* H, const float* xin, float* Xout, bf16_t* XB, float* RS, const float* g, float c, int wave, int lane, int m_begin = -1, int m_count = 0) {
    const int mb = (m_begin < 0) ? bidx() * 8 + wave : m_begin + wave, me = (m_begin < 0) ? MT : m_begin + m_count, mstep = (m_begin < 0) ? gridDim.x * 8 : 8;
#define BFX4(w) (f32x4){__builtin_bit_cast(float, (w).x << 16), __builtin_bit_cast(float, (w).x & 0xffff0000u), __builtin_bit_cast(float, (w).y << 16), __builtin_bit_cast(float, (w).y & 0xffff0000u)}
    if (H) {
        f32x4 gv[8];
#pragma unroll
        for (int i = 0; i < 8; ++i) gv[i] = *(const f32x4*)(g + (lane + 64 * i) * 4);
        for (int m = mb; m < me; m += 2 * mstep) {
            const int m2 = (m + mstep < me) ? m + mstep : m;
            u32x2 hw[2][8], xw[2][8];
#pragma unroll
            for (int i = 0; i < 8; ++i) { const int o = (lane + 64 * i) * 4;
                hw[0][i] = *(const u32x2*)(H + (size_t)m * DM + o); xw[0][i] = *(const u32x2*)(XB + (size_t)m * DM + o);
                hw[1][i] = *(const u32x2*)(H + (size_t)m2 * DM + o); xw[1][i] = *(const u32x2*)(XB + (size_t)m2 * DM + o); }
#pragma unroll
            for (int r = 0; r < 2; ++r) {
                const int mr = r ? m2 : m;
                if (r == 1 && m2 == m) break;
                float ss = 0.f;
#pragma unroll
                for (int i = 0; i < 8; ++i) { const f32x4 hh = BFX4(hw[r][i]); ss += dot4(hh, hh); }
                ss = wave_sum(ss); const float rstd = rsqrtf(ss * (1.0f / DM) + 1e-6f) * c;
                float s2 = 0.f;
#pragma unroll
                for (int i = 0; i < 8; ++i) {
                    const size_t o = (size_t)mr * DM + (lane + 64 * i) * 4;
                    const f32x4 hh = BFX4(hw[r][i]); f32x4 x = BFX4(xw[r][i]);
                    x = x + hh * rstd * gv[i];
                    if (Xout) *(f32x4*)(Xout + o) = x;
                    s2 += dot4(x, x);
                    u32x2 w; w.x = cvt_pk_bf16(x.x, x.y); w.y = cvt_pk_bf16(x.z, x.w); *(u32x2*)(XB + o) = w;
                }
                s2 = wave_sum(s2);
                if (lane == 0) RS[mr] = rsqrtf(s2 * (1.0f / DM) + 1e-6f);
            }
        }
    } else {
        for (int m = mb; m < me; m += mstep) {
            float s2 = 0.f;
#pragma unroll
            for (int i = 0; i < 8; ++i) {
                const size_t o = (size_t)m * DM + (lane + 64 * i) * 4;
                const f32x4 x = *(const f32x4*)(xin + o);
                if (Xout) *(f32x4*)(Xout + o) = x;
                s2 += dot4(x, x);
                u32x2 w; w.x = cvt_pk_bf16(x.x, x.y); w.y = cvt_pk_bf16(x.z, x.w); *(u32x2*)(XB + o) = w;
            }
            s2 = wave_sum(s2);
            if (lane == 0) RS[m] = rsqrtf(s2 * (1.0f / DM) + 1e-6f);
        }
    }
#undef BFX4
}

__device__ __forceinline__ void weight_tile(const Params& p, int gt, LAS unsigned char* lds) {
    unsigned char* ws = p.ws;
    const int l = gt / 2536; int r = gt - l * 2536;
    const float* src; int ld, K, ntn, mode = 0; const float* gv = nullptr; bf16_t* dst;
    if (r < 1376) { const int which = r >= 688; r -= which * 688; src = p.in[which ? 36 : 2] + (size_t)l * DM * 2 * FF; ld = 2 * FF; K = DM; ntn = 43; mode = 1; gv = p.in[which ? 35 : 1] + l * DM; dst = (bf16_t*)(ws + WS_WGU + (size_t)(l * 2 + which) * SZ_WGU); }
    else if (r < 2064) { r -= 1376; const int which = r >= 344; r -= which * 344; src = p.in[which ? 37 : 3] + (size_t)l * FF * DM; ld = DM; K = FF; ntn = 8; dst = (bf16_t*)(ws + WS_WD + (size_t)(l * 2 + which) * SZ_WD); }
    else if (r < 2400) { r -= 2064; src = p.in[6] + (size_t)l * DM * INC; ld = INC; K = DM; ntn = 21; gv = p.in[5] + l * DM; dst = (bf16_t*)(ws + WS_WIN + (size_t)l * SZ_WIN); }
    else if (r < 2528) { r -= 2400; src = p.in[33] + (size_t)l * DM * DM; ld = DM; K = DM; ntn = 8; dst = (bf16_t*)(ws + WS_WOUT + (size_t)l * SZ_WOUT); }
    else { r -= 2528; src = p.in[31] + (size_t)l * 512 * 512; ld = 512; K = 512; ntn = 2; dst = (bf16_t*)(ws + WS_WGLU + (size_t)l * SZ_WGLU); }
    const int kt = r / ntn, nt = r - kt * ntn;
    transpose_tile(src, ld, K, gv, dst, kt, nt, mode, (LAS float*)lds);
}

__device__ __forceinline__ void prologue(const Params& p, LAS unsigned char* lds, int wave, int lane) {
    unsigned char* ws = p.ws; const int tid = tidx(); const int G = gridDim.x;
    for (int gt = bidx(); gt < 2 * 2536 - 1376; gt += G) weight_tile(p, (gt < 2536) ? gt : gt + 1376, lds);
    if (bidx() == 0) ((unsigned*)ws)[tid] = 0u;
    for (int idx = bidx() * 512 + tid; idx < 2 * 2304 * 256; idx += G * 512) {
        const int l = idx / (2304 * 256); const int r = idx - l * (2304 * 256); const int n = r >> 8, k = r & 255;
        float v = 0.f;
        if (n < 768) { if (k < 64) v = p.in[9][((size_t)l * 64 + k) * 768 + n]; }
        else if (n < 1536) { if (k >= 64 && k < 128) v = p.in[11][((size_t)l * 64 + (k - 64)) * 768 + (n - 768)]; }
        else { if (k >= 128) v = p.in[12][((size_t)l * 128 + (k - 128)) * 768 + (n - 1536)]; }
        ((bf16_t*)(ws + WS_WLORA))[idx] = (bf16_t)(cvt_pk_bf16(v, 0.f) & 0xffffu);
    }
    for (int idx = bidx() * 512 + tid; idx < 2 * 2048; idx += G * 512) {
        const int l = idx >> 11, gn = idx & 2047, g = gn >> 6;
        float* tab = (float*)(ws + WS_S5TAB + (size_t)l * SZ_S5TAB);
        const float dt = expf(p.in[25][l * 32 + g]); const float ar = p.in[23][l * 2048 + gn], ai = p.in[24][l * 2048 + gn];
        const float mag = expf(dt * ar); const float abr = mag * cosf(dt * ai), abi = mag * sinf(dt * ai);
        const float den = ar * ar + ai * ai; const float nr = abr - 1.0f, ni = abi;
        const float cr = (nr * ar + ni * ai) / den, ci = (ni * ar - nr * ai) / den;
        tab[gn * 2] = abr; tab[gn * 2 + 1] = abi;
        const float* br = p.in[26] + ((size_t)l * 2048 + gn) * 16; const float* bi = p.in[27] + ((size_t)l * 2048 + gn) * 16;
#pragma unroll
        for (int c = 0; c < 16; ++c) { tab[4096 + gn * 32 + c * 2] = cr * br[c] - ci * bi[c]; tab[4096 + gn * 32 + c * 2 + 1] = cr * bi[c] + ci * br[c]; }
    }
    row_phase(nullptr, p.in[0], nullptr, (bf16_t*)(ws + WS_XB), (float*)(ws + WS_RS), nullptr, 0.f, wave, lane);
}

__device__ __forceinline__ void la_prep(const Params& p, int l) {
    const float* ZR = (const float*)(p.ws + WS_ZR); bf16_t* LA = (bf16_t*)(p.ws + WS_LA); const float* mu = p.in[7] + l * RWC;
    for (int idx = bidx() * 512 + tidx(); idx < MT * 64; idx += gridDim.x * 512) {
        const int m = idx >> 6, c4 = (idx & 63) * 4; const int col = 2304 + c4;
        const f32x4 zc = *(const f32x4*)(ZR + (size_t)m * RWC + col);
        f32x4 zp = {0.f, 0.f, 0.f, 0.f}; if (m & (SEQ - 1)) zp = *(const f32x4*)(ZR + (size_t)(m - 1) * RWC + col);
        const f32x4 m4 = *(const f32x4*)(mu + col);
        f32x4 z = zc + (zp - zc) * m4;
        if (c4 < 64) { z.x = tanhf(z.x); z.y = tanhf(z.y); z.z = tanhf(z.z); z.w = tanhf(z.w); }
        else if (c4 >= 128) { z.x = sigmoidf_(z.x); z.y = sigmoidf_(z.y); z.z = sigmoidf_(z.z); z.w = sigmoidf_(z.w); }
        u32x2 w; w.x = cvt_pk_bf16(z.x, z.y); w.y = cvt_pk_bf16(z.z, z.w);
        *(u32x2*)(LA + (size_t)m * 256 + c4) = w;
    }
}

__device__ __forceinline__ float gelu_tanh(float x) { const float t = tanhf(0.7978845608028654f * (x + 0.044715f * x * x * x)); return 0.5f * x * (1.0f + t); }

template <int PASS>
__device__ __forceinline__ void s5_scan(const Params& p, int l, int widx, int nw, int beff, int nblk, int lane, LAS unsigned char* lds) {
    if (widx < 0 || widx >= nw || beff < 0) return;
    unsigned char* ws = p.ws;
    LAS float* ub = (LAS float*)(lds + widx * 19456);
    LAS float* xb = ub + 512;
    LAS float* ct = xb + 16 * 132;
    const float* ZS = (const float*)(ws + WS_ZS); const float* tab = (const float*)(ws + WS_S5TAB + (size_t)l * SZ_S5TAB);
    float* XE = (float*)(ws + WS_XE);
    float* YS = (float*)(ws + WS_YS); bf16_t* YSB = (bf16_t*)(ws + WS_YSB);
    for (int u = widx * nblk + beff; u < 1024; u += nw * nblk) {
        const int c = u & 15, g = (u >> 4) & 31, b = u >> 9; const int gn = g * 64 + lane;
        const float ar = tab[gn * 2], ai = tab[gn * 2 + 1];
        float br[16], bi[16];
#pragma unroll
        for (int q = 0; q < 8; ++q) { const f32x4 v = *(const f32x4*)(tab + 4096 + gn * 32 + q * 4); br[2 * q] = v.x; bi[2 * q] = v.y; br[2 * q + 1] = v.z; bi[2 * q + 1] = v.w; }
        float xr = 0.f, xi = 0.f;
        if (PASS == 2) {
            float pr = ar, pi = ai;
#pragma unroll
            for (int i = 0; i < 8; ++i) { const float r2 = pr * pr - pi * pi, i2 = 2.f * pr * pi; pr = r2; pi = i2; }
            for (int cp = 0; cp < c; ++cp) { const int up = (u & ~15) + cp; const float er = XE[(up * 64 + lane) * 2], ei = XE[(up * 64 + lane) * 2 + 1];
                const float nr = pr * xr - pi * xi + er, ni = pr * xi + pi * xr + ei; xr = nr; xi = ni; }
#pragma unroll
            for (int cc = 0; cc < 16; ++cc) { ct[cc * 132 + lane] = p.in[28][((size_t)l * 32 + g) * 1024 + cc * 64 + lane]; ct[cc * 132 + 64 + lane] = -p.in[29][((size_t)l * 32 + g) * 1024 + cc * 64 + lane]; }
        }
        const int m0 = b * SEQ + c * 256;
        f32x4 un = *(const f32x4*)(ZS + (size_t)(m0 + (lane >> 2)) * 512 + g * 16 + (lane & 3) * 4);
        for (int bt = 0; bt < 16; ++bt) {
            LAS float* ubc = ub + (bt & 1) * 256;
            *(LAS f32x4*)(ubc + lane * 4) = un;
            if (bt + 1 < 16) un = *(const f32x4*)(ZS + (size_t)(m0 + (bt + 1) * 16 + (lane >> 2)) * 512 + g * 16 + (lane & 3) * 4);
            WAVE_SYNC();
#pragma unroll 4
            for (int s = 0; s < 16; ++s) {
                const f32x4 u0 = *(LAS f32x4*)(ubc + s * 16), u1 = *(LAS f32x4*)(ubc + s * 16 + 4), u2 = *(LAS f32x4*)(ubc + s * 16 + 8), u3 = *(LAS f32x4*)(ubc + s * 16 + 12);
                float bur = 0.f, bui = 0.f;
#pragma unroll
                for (int j = 0; j < 4; ++j) { bur += br[j] * u0[j]; bui += bi[j] * u0[j]; }
#pragma unroll
                for (int j = 0; j < 4; ++j) { bur += br[4 + j] * u1[j]; bui += bi[4 + j] * u1[j]; }
#pragma unroll
                for (int j = 0; j < 4; ++j) { bur += br[8 + j] * u2[j]; bui += bi[8 + j] * u2[j]; }
#pragma unroll
                for (int j = 0; j < 4; ++j) { bur += br[12 + j] * u3[j]; bui += bi[12 + j] * u3[j]; }
                const float nxr = ar * xr - ai * xi + bur, nxi = ar * xi + ai * xr + bui; xr = nxr; xi = nxi;
                if (PASS == 2) { xb[s * 132 + lane] = xr; xb[s * 132 + 64 + lane] = xi; }
            }
            if (PASS == 2) {
                WAVE_SYNC();
                const int s = lane >> 2, c4 = lane & 3;
                f32x4 y = {0.f, 0.f, 0.f, 0.f};
#pragma unroll 4
                for (int n4 = 0; n4 < 32; ++n4) {
                    const f32x4 xv = *(LAS f32x4*)(xb + s * 132 + n4 * 4);
#pragma unroll
                    for (int j = 0; j < 4; ++j) { const f32x4 cv = *(LAS f32x4*)(ct + (c4 * 4 + j) * 132 + n4 * 4); y[j] += dot4(xv, cv); }
                }
                const f32x4 uu = *(LAS f32x4*)(ubc + s * 16 + c4 * 4);
                const f32x4 dsk = *(const f32x4*)(p.in[30] + l * 512 + g * 16 + c4 * 4);
                y = y + dsk * uu;
                y.x = gelu_tanh(y.x); y.y = gelu_tanh(y.y); y.z = gelu_tanh(y.z); y.w = gelu_tanh(y.w);
                const size_t o = (size_t)(m0 + bt * 16 + s) * 512 + g * 16 + c4 * 4;
                *(f32x4*)(YS + o) = y;
                u32x2 w; w.x = cvt_pk_bf16(y.x, y.y); w.y = cvt_pk_bf16(y.z, y.w); *(u32x2*)(YSB + o) = w;
                WAVE_SYNC();
            }
        }
        if (PASS == 1) { XE[(u * 64 + lane) * 2] = xr; XE[(u * 64 + lane) * 2 + 1] = xi; }
    }
}
__device__ __forceinline__ void s5_combine(const Params& p, int l, int unit0, int ustride, int lane) {
    const float* tab = (const float*)(p.ws + WS_S5TAB + (size_t)l * SZ_S5TAB); const float* XE = (const float*)(p.ws + WS_XE); float* XIN = (float*)(p.ws + WS_XIN);
    for (int bg = unit0; bg < 64; bg += ustride) {
        const int g = bg & 31; float ar = tab[(g * 64 + lane) * 2], ai = tab[(g * 64 + lane) * 2 + 1];
#pragma unroll
        for (int i = 0; i < 8; ++i) { const float r2 = ar * ar - ai * ai, i2 = 2.f * ar * ai; ar = r2; ai = i2; }
        float xr = 0.f, xi = 0.f; asm volatile("" : "+v"(xr), "+v"(xi));
        for (int c = 0; c < 16; ++c) {
            const int u = bg * 16 + c;
            XIN[(u * 64 + lane) * 2] = xr; XIN[(u * 64 + lane) * 2 + 1] = xi;
            const float er = XE[(u * 64 + lane) * 2], ei = XE[(u * 64 + lane) * 2 + 1];
            const float nr = ar * xr - ai * xi + er, ni = ar * xi + ai * xr + ei; xr = nr; xi = ni;
        }
    }
}
template <int PASS>
__device__ __forceinline__ void rwkv_scan(const Params& p, int l, int wave, int lane, LAS unsigned char* lds) {
    if (wave >= 3) return;
    constexpr int NB = 2, NBT = 128 / NB;
    const int G = gridDim.x; unsigned char* ws = p.ws;
    LAS float* sb = (LAS float*)(lds + wave * 8192);
    LAS float* cb = sb + 1024 + lane;
    const float* ZR = (const float*)(ws + WS_ZR); const bf16_t* LR = (const bf16_t*)(ws + WS_LR);
    const float* SIN = (const float*)(ws + WS_SIN); bf16_t* YCAT = (bf16_t*)(ws + WS_YCAT);
    for (int u = wave * G + bidx(); u < 768; u += 3 * G) {
        const int c = u & 31, bh = u >> 5; const int b = bh / 12, h = bh - b * 12; const int ch = h * 64 + lane;
        const int m0 = b * SEQ + c * 128;
        cb[0] = p.in[7][l * RWC + ch]; cb[64] = p.in[7][l * RWC + 768 + ch]; cb[128] = p.in[7][l * RWC + 1536 + ch];
        cb[192] = p.in[13][l * 768 + ch]; cb[256] = p.in[14][l * 768 + ch]; cb[320] = p.in[8][l * 768 + ch]; cb[384] = p.in[10][l * 768 + ch];
        cb[448] = p.in[15][l * 768 + ch];
        if (PASS == 2) { cb[512] = p.in[16][l * 768 + ch]; cb[576] = p.in[17][l * 768 + ch]; }
        f32x2 s[32]; f32x2 pp[32];
        if (PASS == 1) {
#pragma unroll
            for (int j = 0; j < 32; ++j) { int ll = lane; asm volatile("" : "+v"(ll)); s[j] = (f32x2){0.f, 0.f}; pp[j] = (f32x2){(2 * j == ll) ? 1.f : 0.f, (2 * j + 1 == ll) ? 1.f : 0.f}; }
        } else {
#pragma unroll
            for (int j = 0; j < 32; ++j) { s[j] = (f32x2){SIN[((size_t)u * 64 + 2 * j) * 64 + lane], SIN[((size_t)u * 64 + 2 * j + 1) * 64 + lane]}; }
        }
        float pr = 0.f, pk = 0.f, pv = 0.f;
        if (c != 0) { const float* zp = ZR + (size_t)(m0 - 1) * RWC; pr = zp[ch]; pk = zp[768 + ch]; pv = zp[1536 + ch]; }
        float zr4[NB], zk4[NB], zv4[NB], de4[NB], aa4[NB], gg4[NB];
#pragma unroll
        for (int q = 0; q < NB; ++q) { const float* zb = ZR + (size_t)(m0 + q) * RWC; const bf16_t* lb = LR + (size_t)(m0 + q) * 2304; zr4[q] = zb[ch]; zk4[q] = (zb + 768)[ch]; zv4[q] = (zb + 1536)[ch]; de4[q] = BF2F(lb[ch]); aa4[q] = BF2F((lb + 768)[ch]); gg4[q] = (PASS == 2) ? BF2F((lb + 1536)[ch]) : 0.f; }
        for (int bt = 0; bt < NBT; ++bt) {
            float vv[NB];
            const float mu_r = cb[0], mu_k = cb[64], mu_v = cb[128], kkc = cb[192], kac = cb[256], w0c = cb[320], a0c = cb[384]; const float rkc = cb[448];
#pragma unroll
            for (int q = 0; q < NB; ++q) {
                const float r = zr4[q] + (pr - zr4[q]) * mu_r, k = zk4[q] + (pk - zk4[q]) * mu_k, v = zv4[q] + (pv - zv4[q]) * mu_v;
                pr = zr4[q]; pk = zk4[q]; pv = zv4[q];
                float kk = k * kkc; const float n2 = wave_sum(kk * kk); kk = kk * __builtin_amdgcn_rcpf(fmaxf(__builtin_amdgcn_sqrtf(n2), 1e-12f));
                const float a = sigmoidf_(a0c + aa4[q]); const float kmod = k * (1.0f + (a - 1.0f) * kac);
                LAS float* q5 = sb + q * 512 + lane;
                q5[0] = decay_of(w0c + de4[q]); q5[64] = -kk; q5[128] = kk * a; q5[192] = kmod; q5[256] = r; q5[320] = v;
                vv[q] = v;
                if (PASS == 2) { q5[384] = wave_sum(r * kmod * rkc) * v; q5[448] = gg4[q]; }
                if (PASS == 1) { const float bo = wave_sum(r * kmod * rkc) * v; ((bf16_t*)(ws + WS_BON))[(size_t)(m0 + bt * NB + q) * 768 + ch] = (bf16_t)(cvt_pk_bf16(bo, 0.f) & 0xffffu); }
            }
            if (bt + 1 < NBT) {
#pragma unroll
                for (int q = 0; q < NB; ++q) { const float* zb = ZR + (size_t)(m0 + (bt + 1) * NB + q) * RWC; const bf16_t* lb = LR + (size_t)(m0 + (bt + 1) * NB + q) * 2304; zr4[q] = zb[ch]; zk4[q] = (zb + 768)[ch]; zv4[q] = (zb + 1536)[ch]; de4[q] = BF2F(lb[ch]); aa4[q] = BF2F((lb + 768)[ch]); gg4[q] = (PASS == 2) ? BF2F((lb + 1536)[ch]) : 0.f; }
            }
            WAVE_SYNC();
            float yo[NB];
#define SB_ __builtin_amdgcn_sched_barrier(0)
#define LDV(dst, n, src) _Pragma("unroll") for (int j_ = 0; j_ < (n); ++j_) dst[j_] = (src)[j_]
            if (PASS == 1) {
                f32x4 H3[3][4];
#define RW1_VEC(k) (((k) < 4) ? 16 : (((k) >= 16) ? 64 : (((((k) - 4) % 3) == 0) ? 0 : (((((k) - 4) % 3) == 1) ? 32 : 48))))
#define RW1_QTR(k) (((k) < 4) ? (k) : (((k) >= 16) ? ((k) - 16) : (((k) - 4) / 3)))
#define RW1_PTR(g) ((const LAS f32x4*)(sb + ((g) / 20) * 512) + RW1_VEC((g) % 20) + RW1_QTR((g) % 20) * 4)
                LDV(H3[0], 4, RW1_PTR(0)); LDV(H3[1], 4, RW1_PTR(1));
#pragma unroll
                for (int q = 0; q < NB; ++q) {
                    const float vq = sb[q * 512 + 320 + lane];
                    f32x2 as0, ap0, sas2, sap2; const f32x2 v2 = {vq, vq};
#pragma unroll
                    for (int k = 0; k < 20; ++k) {
                        const int g = q * 20 + k; const int c8 = RW1_QTR(k) * 8; const int t = (k < 4) ? -1 : ((k >= 16) ? 3 : ((k - 4) % 3));
                        if (g + 2 < NB * 20) { LDV(H3[(g + 2) % 3], 4, RW1_PTR(g + 2)); }
                        SB_;
#pragma unroll
                        for (int j = 0; j < 4; ++j) {
                            const f32x4 o4 = H3[g % 3][j]; const f32x2 lo = {o4.x, o4.y}, hi = {o4.z, o4.w};
                            if (t < 0) { if (k == 0 && j == 0) { as0 = s[c8] * lo; ap0 = pp[c8] * lo; } else { as0 += s[c8 + 2 * j] * lo; ap0 += pp[c8 + 2 * j] * lo; } as0 += s[c8 + 2 * j + 1] * hi; ap0 += pp[c8 + 2 * j + 1] * hi; }
                            else if (t == 0) { s[c8 + 2 * j] *= lo; s[c8 + 2 * j + 1] *= hi; pp[c8 + 2 * j] *= lo; pp[c8 + 2 * j + 1] *= hi; }
                            else if (t == 1) { s[c8 + 2 * j] += sas2 * lo; s[c8 + 2 * j + 1] += sas2 * hi; pp[c8 + 2 * j] += sap2 * lo; pp[c8 + 2 * j + 1] += sap2 * hi; }
                            else if (t == 2) { s[c8 + 2 * j] += v2 * lo; s[c8 + 2 * j + 1] += v2 * hi; }
                            else { if (k == 16 && j == 0) { as0 = s[c8] * lo; ap0 = pp[c8] * lo; } else { as0 += s[c8 + 2 * j] * lo; ap0 += pp[c8 + 2 * j] * lo; } as0 += s[c8 + 2 * j + 1] * hi; ap0 += pp[c8 + 2 * j + 1] * hi; }
                        }
                        if (k == 19) { const size_t o = (size_t)(m0 + bt * NB + q) * 768 + ch; ((float*)(ws + WS_YL))[o] = as0.x + as0.y; ((float*)(ws + WS_QQ))[o] = ap0.x + ap0.y; }
                        if (k == 3) { const float sas = as0.x + as0.y, sap = ap0.x + ap0.y; sas2 = (f32x2){sas, sas}; sap2 = (f32x2){sap, sap}; }
                        SB_;
                    }
                }
#undef RW1_PTR
#undef RW1_QTR
#undef RW1_VEC
            } else {
                f32x4 H3[2][8];
#define RW2_PTR(g) ((const LAS f32x4*)(sb + ((g) / 10) * 512) + ((((g) % 10) / 2 == 0) ? 16 : ((((g) % 10) / 2 == 1) ? 0 : ((((g) % 10) / 2 == 2) ? 32 : ((((g) % 10) / 2 == 3) ? 48 : 64)))) + ((g) % 2) * 8)
                LDV(H3[0], 8, RW2_PTR(0));
#pragma unroll
                for (int q = 0; q < NB; ++q) {
                    f32x2 as0, as1, ay0, ay1, sas2; const f32x2 v2 = {vv[q], vv[q]};
#pragma unroll
                    for (int k = 0; k < 10; ++k) {
                        const int g = q * 10 + k; const int h16 = (k & 1) * 16;
                        if (g + 1 < NB * 10) { LDV(H3[(g + 1) % 2], 8, RW2_PTR(g + 1)); }
                        SB_;
#pragma unroll
                        for (int j = 0; j < 8; ++j) {
                            const f32x4 o4 = H3[g % 2][j]; const f32x2 lo = {o4.x, o4.y}, hi = {o4.z, o4.w};
                            if (k < 2) { if (k == 0 && j == 0) { as0 = s[0] * lo; as1 = s[1] * hi; } else { as0 += s[h16 + 2 * j] * lo; as1 += s[h16 + 2 * j + 1] * hi; } }
                            else if (k < 4) { s[h16 + 2 * j] *= lo; s[h16 + 2 * j + 1] *= hi; }
                            else if (k < 6) { s[h16 + 2 * j] += sas2 * lo; s[h16 + 2 * j + 1] += sas2 * hi; }
                            else if (k < 8) { s[h16 + 2 * j] += v2 * lo; s[h16 + 2 * j + 1] += v2 * hi; }
                            else { if (k == 8 && j == 0) { ay0 = s[0] * lo; ay1 = s[1] * hi; } else { ay0 += s[h16 + 2 * j] * lo; ay1 += s[h16 + 2 * j + 1] * hi; } }
                        }
                        if (k == 1) { const float sas = (as0.x + as0.y) + (as1.x + as1.y); sas2 = (f32x2){sas, sas}; }
                        SB_;
                    }
                    yo[q] = (ay0.x + ay0.y) + (ay1.x + ay1.y);
                }
#undef RW2_PTR
            }
#undef SB_
#undef LDV
            if (PASS == 2) {
#pragma unroll
                for (int q = 0; q < NB; ++q) {
                    const float mean = wave_sum(yo[q]) * (1.0f / 64.0f); const float d = yo[q] - mean; const float var = wave_sum(d * d) * (1.0f / 64.0f);
                    const float gnw = cb[512], gnb = cb[576]; const float yn = d * rsqrtf(var + 64e-5f) * gnw + gnb; const float o = (yn + sb[q * 512 + 384 + lane]) * sb[q * 512 + 448 + lane];
                    YCAT[(size_t)(m0 + bt * NB + q) * DM + ch] = (bf16_t)(cvt_pk_bf16(o, 0.f) & 0xffffu);
                }
            }
            WAVE_SYNC();
        }
        if (PASS == 1) {
            int ll = lane; asm volatile("" : "+v"(ll));
            unsigned char* wsl = p.ws; asm volatile("" : "+s"(wsl)); int ul = u; asm volatile("" : "+s"(ul));
            float* sp = (float*)(wsl + WS_SEND) + (size_t)ul * 8192 + ll;
#pragma unroll
            for (int j = 0; j < 32; ++j) {
                sp[(2 * j) * 64] = s[j].x; sp[(2 * j + 1) * 64] = s[j].y;
                sp[(64 + 2 * j) * 64] = pp[j].x; sp[(64 + 2 * j + 1) * 64] = pp[j].y;
            }
        }
    }
}
__device__ __forceinline__ void rwkv_out(const Params& p, int l, int wave, int lane, LAS unsigned char* lds) {
    unsigned char* ws = p.ws; const int G = gridDim.x;
    const float* SIN = (const float*)(ws + WS_SIN); const float* YL = (const float*)(ws + WS_YL); const float* QQ = (const float*)(ws + WS_QQ);
    const bf16_t* BON = (const bf16_t*)(ws + WS_BON); const bf16_t* LR = (const bf16_t*)(ws + WS_LR); bf16_t* YCAT = (bf16_t*)(ws + WS_YCAT);
    LAS float* qb = (LAS float*)(lds + wave * 1024);
    for (int u2 = wave * G + bidx(); u2 < 3072; u2 += 8 * G) {
        const int u = u2 >> 2, qt = u2 & 3; const int c = u & 31, bh = u >> 5; const int b = bh / 12, h = bh - b * 12; const int ch = h * 64 + lane;
        const int m0 = b * SEQ + c * 128 + qt * 32;
        const float gnw = p.in[16][l * 768 + ch], gnb = p.in[17][l * 768 + ch];
        f32x2 s[32];
        { const float* sb_ = SIN + (size_t)u * 4096 + lane;
#pragma unroll
          for (int j = 0; j < 32; ++j) s[j] = (f32x2){sb_[(2 * j) * 64], sb_[(2 * j + 1) * 64]}; }
        float q4[4], y4[4], b4[4], g4[4];
#pragma unroll
        for (int q = 0; q < 4; ++q) { const size_t o = (size_t)(m0 + q) * 768; q4[q] = (QQ + o)[ch]; y4[q] = (YL + o)[ch]; b4[q] = BF2F((BON + o)[ch]); g4[q] = BF2F((LR + (size_t)(m0 + q) * 2304 + 1536)[ch]); }
        for (int bt = 0; bt < 8; ++bt) {
            float yc[4], bc[4], gc[4];
#pragma unroll
            for (int q = 0; q < 4; ++q) { qb[q * 64 + lane] = q4[q]; yc[q] = y4[q]; bc[q] = b4[q]; gc[q] = g4[q]; }
            if (bt + 1 < 8) {
#pragma unroll
                for (int q = 0; q < 4; ++q) { const size_t o = (size_t)(m0 + (bt + 1) * 4 + q) * 768; q4[q] = (QQ + o)[ch]; y4[q] = (YL + o)[ch]; b4[q] = BF2F((BON + o)[ch]); g4[q] = BF2F((LR + (size_t)(m0 + (bt + 1) * 4 + q) * 2304 + 1536)[ch]); }
            }
            WAVE_SYNC();
#pragma unroll
            for (int q = 0; q < 4; ++q) {
                const LAS f32x4* Q4 = (const LAS f32x4*)(qb + q * 64);
                f32x2 a0 = {0.f, 0.f}, a1 = {0.f, 0.f};
#pragma unroll
                for (int j = 0; j < 16; ++j) { const f32x4 v = Q4[j]; a0 += s[2 * j] * (f32x2){v.x, v.y}; a1 += s[2 * j + 1] * (f32x2){v.z, v.w}; }
                const float yo = yc[q] + (a0.x + a0.y) + (a1.x + a1.y);
                const float mean = wave_sum(yo) * (1.0f / 64.0f); const float d = yo - mean; const float var = wave_sum(d * d) * (1.0f / 64.0f);
                const float o = (d * rsqrtf(var + 64e-5f) * gnw + gnb + bc[q]) * gc[q];
                YCAT[(size_t)(m0 + bt * 4 + q) * DM + ch] = (bf16_t)(cvt_pk_bf16(o, 0.f) & 0xffffu);
            }
            WAVE_SYNC();
        }
    }
}
__device__ __forceinline__ void rwkv_combine(const Params& p, int bh, int wave, int lane, LAS unsigned char* lds) {
    LAS float* xs = (LAS float*)lds;
    LAS float* pw = (LAS float*)(lds + 16384 + wave * 2048);
    const float* SEND = (const float*)(p.ws + WS_SEND) + (size_t)bh * 32 * 8192 + (size_t)(wave * 8) * 64 + lane; float* SIN = (float*)(p.ws + WS_SIN) + (size_t)bh * 32 * 4096 + (size_t)(wave * 8) * 64 + lane;
    f32x2 s[32];
#pragma unroll
    for (int j = 0; j < 32; ++j) s[j] = (f32x2){0.f, 0.f};
    float own[8], pj[4][8], sl[4][8];
#pragma unroll
    for (int jj = 0; jj < 8; ++jj) own[jj] = 0.f;
#pragma unroll
    for (int d = 0; d < 4; ++d)
#pragma unroll
        for (int jj = 0; jj < 8; ++jj) { pj[d][jj] = SEND[(size_t)d * 8192 + (64 + jj) * 64]; sl[d][jj] = SEND[(size_t)d * 8192 + jj * 64]; }
    for (int c4 = 0; c4 < 8; ++c4) {
#pragma unroll
        for (int cc = 0; cc < 4; ++cc) {
            const int c = c4 * 4 + cc;
            float slc[8];
#pragma unroll
            for (int jj = 0; jj < 8; ++jj) { SIN[(size_t)c * 4096 + jj * 64] = own[jj]; pw[jj * 64 + lane] = pj[cc][jj]; slc[jj] = sl[cc][jj]; }
            if (c + 4 < 32) {
#pragma unroll
                for (int jj = 0; jj < 8; ++jj) { pj[cc][jj] = SEND[(size_t)(c + 4) * 8192 + (64 + jj) * 64]; sl[cc][jj] = SEND[(size_t)(c + 4) * 8192 + jj * 64]; }
            }
            WAVE_SYNC();
#pragma unroll
            for (int jj = 0; jj < 8; ++jj) {
                f32x2 a0 = {0.f, 0.f}, a1 = {0.f, 0.f};
#pragma unroll
                for (int i4 = 0; i4 < 16; ++i4) { const f32x4 pv = *(const LAS f32x4*)(pw + jj * 64 + i4 * 4); a0 += s[2 * i4] * (f32x2){pv.x, pv.y}; a1 += s[2 * i4 + 1] * (f32x2){pv.z, pv.w}; }
                own[jj] = slc[jj] + (a0.x + a0.y) + (a1.x + a1.y);
                xs[(wave * 8 + jj) * 64 + lane] = own[jj];
            }
            __syncthreads();
#pragma unroll
            for (int j = 0; j < 32; ++j) s[j] = (f32x2){xs[(2 * j) * 64 + lane], xs[(2 * j + 1) * 64 + lane]};
            __syncthreads();
        }
    }
}

constexpr int KP = 136, VP = 72;
constexpr int ATT_BUF = 64 * KP * 2 + 128 * VP * 2;
__device__ __forceinline__ void attn_phase(const Params& p, int l, int wave, int lane, LAS unsigned char* lds, int early) {
    const int tid = tidx(); unsigned char* ws = p.ws;
    const bf16_t* DAQK = (const bf16_t*)(ws + WS_DAQK); const bf16_t* VT = (const bf16_t*)(ws + WS_VT); bf16_t* YCAT = (bf16_t*)(ws + WS_YCAT);
    const float lam_init = 0.8f - 0.6f * expf(-0.3f * (float)l);
    const float d1 = wave_sum(p.in[18][l * 64 + lane] * p.in[19][l * 64 + lane]), d2 = wave_sum(p.in[20][l * 64 + lane] * p.in[21][l * 64 + lane]);
    const float lam = expf(d1) - expf(d2) + lam_init;
    const int sub = wave >> 2, rq = (wave & 3) * 32, qi = lane & 15, g4 = lane >> 4;
    const int x16 = (lane ^ 16) << 2, x32 = (lane ^ 32) << 2;
#define SHX(v, a) __builtin_bit_cast(float, __builtin_amdgcn_ds_bpermute((a), __builtin_bit_cast(int, (v))))
    unsigned* aq = (unsigned*)ws + 256 + l; unsigned* dn = (unsigned*)ws + 264 + l;
    volatile LAS int* ubox = (volatile LAS int*)(lds + 143360);
    LAS float* swl = (LAS float*)(lds + 143488);
    if (tid < 128) swl[tid] = p.in[22][l * 128 + tid] * (1.0f - lam_init);
    for (;;) {
        __syncthreads();
        if (tid == 0) { int un = 384;
            if (!(early && __hip_atomic_load(dn, __ATOMIC_RELAXED, __HIP_MEMORY_SCOPE_AGENT) >= 24u)) un = (int)__hip_atomic_fetch_add(aq, 1u, __ATOMIC_RELAXED, __HIP_MEMORY_SCOPE_AGENT);
            *ubox = un; }
        __syncthreads();
        const int u = *ubox;
        if (u >= 384) break;
        const int qb = 31 - u / 12, rem = u % 12, b = rem / 6, h = rem % 6;
        const int q0 = qb * 128, kl = 2 * qb + 1;
        bf16x8 qf[2][2];
#pragma unroll
        for (int rt = 0; rt < 2; ++rt) { const bf16_t* qp = DAQK + (size_t)(b * SEQ + q0 + rq + 16 * rt + qi) * 1536 + h * 128 + sub * 64 + g4 * 8; qf[rt][0] = *(const bf16x8*)qp; qf[rt][1] = *(const bf16x8*)(qp + 32); }
        f32x4 o[2][8];
#pragma unroll
        for (int rt = 0; rt < 2; ++rt)
#pragma unroll
            for (int e = 0; e < 8; ++e) o[rt][e] = (f32x4){0.f, 0.f, 0.f, 0.f};
        float mrun[2] = {-1e30f, -1e30f}, lrun[2] = {0.f, 0.f};
        const int kr0 = tid >> 4, kc0 = tid & 15;
        const int vr0 = tid >> 3, vc0 = tid & 7;
        const bf16_t* kbase = DAQK + (size_t)(b * SEQ) * 1536 + 768 + h * 128 + kc0 * 8;
        const bf16_t* vbase = VT + (size_t)(b * 768 + h * 128) * SEQ + vc0 * 8;
        u32x4 kreg[2], vreg[2];
#define ATT_LOADR(KR, VR, kb) do { KR[0] = *(const u32x4*)(kbase + (size_t)((kb) * 64 + kr0) * 1536); KR[1] = *(const u32x4*)(kbase + (size_t)((kb) * 64 + kr0 + 32) * 1536); \
        VR[0] = *(const u32x4*)(vbase + (size_t)vr0 * SEQ + (kb) * 64); VR[1] = *(const u32x4*)(vbase + (size_t)(vr0 + 64) * SEQ + (kb) * 64); } while (0)
#define ATT_STORER(KR, VR, buf) do { LAS unsigned char* kb_ = lds + (buf) * ATT_BUF; LAS unsigned char* vb_ = kb_ + 64 * KP * 2; \
        *(LAS u32x4*)(kb_ + (kr0 * KP + kc0 * 8) * 2) = KR[0]; *(LAS u32x4*)(kb_ + ((kr0 + 32) * KP + kc0 * 8) * 2) = KR[1]; \
        *(LAS u32x4*)(vb_ + (vr0 * VP + vc0 * 8) * 2) = VR[0]; *(LAS u32x4*)(vb_ + ((vr0 + 64) * VP + vc0 * 8) * 2) = VR[1]; } while (0)
#define ATT_COMPUTE(kb) do { \
            const LAS unsigned char* kt = lds + ((kb) & 1) * ATT_BUF; const LAS unsigned char* vt = kt + 64 * KP * 2; \
            f32x4 st[2][4]; \
            __builtin_amdgcn_s_setprio(1); \
            _Pragma("unroll") for (int mt = 0; mt < 4; ++mt) { \
                st[0][mt] = (f32x4){0.f, 0.f, 0.f, 0.f}; st[1][mt] = (f32x4){0.f, 0.f, 0.f, 0.f}; \
                _Pragma("unroll") for (int ks = 0; ks < 2; ++ks) { \
                    const bf16x8 ka = *(const LAS bf16x8*)(kt + ((16 * mt + qi) * KP + sub * 64 + ks * 32 + g4 * 8) * 2); \
                    st[0][mt] = __builtin_amdgcn_mfma_f32_16x16x32_bf16(ka, qf[0][ks], st[0][mt], 0, 0, 0); \
                    st[1][mt] = __builtin_amdgcn_mfma_f32_16x16x32_bf16(ka, qf[1][ks], st[1][mt], 0, 0, 0); \
                } \
            } \
            __builtin_amdgcn_s_setprio(0); \
            bf16x8 pb[2][2]; \
            _Pragma("unroll") for (int rt = 0; rt < 2; ++rt) { \
                const int qrel = q0 + rq + 16 * rt - (kb) * 64;            \
                if (qrel < 63) { \
                    _Pragma("unroll") for (int mt = 0; mt < 4; ++mt) \
                        _Pragma("unroll") for (int i = 0; i < 4; ++i) if (16 * mt + 4 * g4 + i > qrel + qi) st[rt][mt][i] = -1e30f; \
                } \
                float mx = st[rt][0][0]; \
                _Pragma("unroll") for (int mt = 0; mt < 4; ++mt) \
                    _Pragma("unroll") for (int i = 0; i < 4; ++i) mx = fmaxf(mx, st[rt][mt][i]); \
                mx = fmaxf(mx, SHX(mx, x16)); mx = fmaxf(mx, SHX(mx, x32)); \
                const float mnew = fmaxf(mrun[rt], mx); const float alpha = __builtin_amdgcn_exp2f(mrun[rt] - mnew); mrun[rt] = mnew; \
                float ps = 0.f; \
                _Pragma("unroll") for (int mt = 0; mt < 4; ++mt) \
                    _Pragma("unroll") for (int i = 0; i < 4; ++i) { const float e = __builtin_amdgcn_exp2f(st[rt][mt][i] - mnew); st[rt][mt][i] = e; ps += e; } \
                lrun[rt] = lrun[rt] * alpha + ps; \
                if (__builtin_amdgcn_ballot_w64(alpha != 1.0f) != 0ull) { _Pragma("unroll") for (int e = 0; e < 8; ++e) o[rt][e] = o[rt][e] * alpha; } \
                _Pragma("unroll") for (int jp = 0; jp < 2; ++jp) { \
                    u32x4 pw4; pw4.x = cvt_pk_bf16(st[rt][2 * jp][0], st[rt][2 * jp][1]); pw4.y = cvt_pk_bf16(st[rt][2 * jp][2], st[rt][2 * jp][3]); \
                    pw4.z = cvt_pk_bf16(st[rt][2 * jp + 1][0], st[rt][2 * jp + 1][1]); pw4.w = cvt_pk_bf16(st[rt][2 * jp + 1][2], st[rt][2 * jp + 1][3]); \
                    pb[rt][jp] = __builtin_bit_cast(bf16x8, pw4); } \
            } \
            __builtin_amdgcn_s_setprio(1); \
            _Pragma("unroll") for (int jp = 0; jp < 2; ++jp) \
                _Pragma("unroll") for (int e = 0; e < 8; ++e) { \
                    const LAS unsigned char* vp = vt + ((16 * e + qi) * VP + 32 * jp + 4 * g4) * 2; \
                    const u32x2 lo = *(const LAS u32x2*)vp, hi = *(const LAS u32x2*)(vp + 32); \
                    u32x4 va4; va4.x = lo.x; va4.y = lo.y; va4.z = hi.x; va4.w = hi.y; const bf16x8 va = __builtin_bit_cast(bf16x8, va4); \
                    o[0][e] = __builtin_amdgcn_mfma_f32_16x16x32_bf16(va, pb[0][jp], o[0][e], 0, 0, 0); \
                    o[1][e] = __builtin_amdgcn_mfma_f32_16x16x32_bf16(va, pb[1][jp], o[1][e], 0, 0, 0); \
                } \
            __builtin_amdgcn_s_setprio(0); \
        } while (0)
        __syncthreads();
        ATT_LOADR(kreg, vreg, 0); ATT_STORER(kreg, vreg, 0);
        __syncthreads();
        for (int kb = 0; kb <= kl; ++kb) {
            if (kb < kl) ATT_LOADR(kreg, vreg, kb + 1);
            ATT_COMPUTE(kb);
            if (kb < kl) ATT_STORER(kreg, vreg, (kb + 1) & 1);
            __syncthreads();
        }
#undef ATT_LOADR
#undef ATT_STORER
#undef ATT_COMPUTE
        float inv[2];
#pragma unroll
        for (int rt = 0; rt < 2; ++rt) { float lt = lrun[rt]; lt += SHX(lt, x16); lt += SHX(lt, x32); inv[rt] = 1.0f / lt; }
        if (sub == 1) {
#pragma unroll
            for (int rt = 0; rt < 2; ++rt) { LAS float* ox = (LAS float*)lds + ((wave & 3) * 2 + rt) * 2048;
#pragma unroll
                for (int e = 0; e < 8; ++e)
#pragma unroll
                    for (int i = 0; i < 4; ++i) ox[(16 * e + 4 * g4 + i) * 16 + qi] = o[rt][e][i] * inv[rt]; }
        }
        __syncthreads();
        if (sub == 0) {
#pragma unroll
            for (int rt = 0; rt < 2; ++rt) {
                const LAS float* ox = (const LAS float*)lds + ((wave & 3) * 2 + rt) * 2048;
                float ssq = 0.f;
#pragma unroll
                for (int e = 0; e < 8; ++e)
#pragma unroll
                    for (int i = 0; i < 4; ++i) { const float v = o[rt][e][i] * inv[rt] - lam * ox[(16 * e + 4 * g4 + i) * 16 + qi]; o[rt][e][i] = v; ssq += v * v; }
                ssq += SHX(ssq, x16); ssq += SHX(ssq, x32);
                const float rn = rsqrtf(ssq * (1.0f / 128.0f) + 1e-5f);
                bf16_t* yp = YCAT + (size_t)(b * SEQ + q0 + rq + 16 * rt + qi) * DM + 768 + h * 128;
#pragma unroll
                for (int e = 0; e < 8; ++e) {
                    const f32x4 sw = *(const LAS f32x4*)(swl + 16 * e + 4 * g4);
                    u32x2 w; w.x = cvt_pk_bf16(o[rt][e][0] * rn * sw.x, o[rt][e][1] * rn * sw.y); w.y = cvt_pk_bf16(o[rt][e][2] * rn * sw.z, o[rt][e][3] * rn * sw.w);
                    *(u32x2*)(yp + 16 * e + 4 * g4) = w;
                }
            }
        }
    }
}
template <class Epi>
__device__ __forceinline__ void run_gemm(LAS unsigned char* lds, const bf16_t* A, const bf16_t* Bt, int N, int K, const Epi& E) {
    pg8::Gemm g; g.A = A; g.Bt = Bt; g.M = MT; g.N = N; g.K = K;
    pg8::StaticOrder S; S.init(MT, N, gridDim.x, bidx());
    pg8::gemm_phase<Epi, pg8::StaticOrder, true, true>(lds, g, S, E);
}

#ifndef PHASE_MASK
#define PHASE_MASK 0xFFFFu
#endif
constexpr unsigned PHM = PHASE_MASK;
#ifndef DUP_MASK
#define DUP_MASK 0
#endif
constexpr unsigned DUPM = DUP_MASK;
#define PON(k) ((PHM >> (k)) & 1u)
__global__ void __launch_bounds__(512, 2) mk_fwd(Params p) {
    extern __shared__ __attribute__((aligned(16))) unsigned char smem[];
    LAS unsigned char* lds = (LAS unsigned char*)smem;
    cg::grid_group grid = cg::this_grid();
    volatile LAS unsigned* xst = (volatile LAS unsigned*)(lds + 143368);
    if (threadIdx.x == 0) { xst[0] = 0u; xst[1] = 0u;
        __hip_atomic_fetch_add((unsigned*)p.ws + 1536 + ((unsigned)__builtin_amdgcn_s_getreg((3 << 11) | 20) & 0xFu), 1u, __ATOMIC_RELAXED, __HIP_MEMORY_SCOPE_AGENT); }
    __syncthreads();
    unsigned char* ws = p.ws;
    bf16_t* XB = (bf16_t*)(ws + WS_XB); float* RS = (float*)(ws + WS_RS); bf16_t* YCAT = (bf16_t*)(ws + WS_YCAT);
    bf16_t* ACT = (bf16_t*)(ws + WS_ACT); bf16_t* H = (bf16_t*)(ws + WS_H);
    for (int ph = p.ph_lo; ph < p.ph_hi; ++ph) {
        const int s_ = (ph == 0) ? -1 : (ph - 1) % NPL;
        int nrep = 1;
        if (DUPM) { const int kind = (ph == 0) ? 0 : ((s_ == 0 || s_ == 13) ? 1 : ((s_ == 1 || s_ == 14 || s_ == 11 || s_ == 5) ? 2 : ((s_ == 2 || s_ == 12 || s_ == 15) ? 3 : ((s_ == 3) ? 4 : (s_ - 4 + 5)))));
            if ((DUPM >> kind) & 1u) nrep = 2; }
        for (int rep = 0; rep < nrep; ++rep) {
        if (rep) grid.sync();
        const int tid = tidx(), lane = tid & 63, wave = __builtin_amdgcn_readfirstlane(tid >> 6);
        if (ph == 0) { if (PON(0)) prologue(p, lds, wave, lane); }
        else {
            const int l = (ph - 1) / NPL, s = (ph - 1) % NPL;
            if ((s == 0 || s == 13) && PON(1)) {
                EpiGU E; E.ACT = ACT; E.rs = RS;
                run_gemm(lds, XB, (const bf16_t*)(ws + WS_WGU + (size_t)(l * 2 + (s == 13)) * SZ_WGU), 2 * FF, DM, E);
            } else if ((s == 1 || s == 14 || s == 11 || s == 5) && PON(2)) {
                EpiBF E; E.C = (s == 5) ? (bf16_t*)(ws + WS_LR) : H; E.ldc = (s == 5) ? 2304 : DM;
                const bf16_t* Ag = (s == 11) ? YCAT : ((s == 5) ? (const bf16_t*)(ws + WS_LA) : ACT);
                const bf16_t* Bg = (s == 11) ? (const bf16_t*)(ws + WS_WOUT + (size_t)l * SZ_WOUT) : ((s == 5) ? (const bf16_t*)(ws + WS_WLORA + (size_t)l * SZ_WLORA) : (const bf16_t*)(ws + WS_WD + (size_t)(l * 2 + (s == 14)) * SZ_WD));
                run_gemm(lds, Ag, Bg, (s == 5) ? 2304 : DM, (s == 11) ? DM : ((s == 5) ? 256 : FF), E);
                if (s != 5 && gridDim.x == 256) {
                    pg8::StaticOrder S; S.init(MT, DM, 256, bidx()); Unit un; S.next(0, un);
                    const int wh = (s == 1) ? 0 : ((s == 11) ? 1 : 2);
                    unsigned* cnt = (unsigned*)ws + (l * 3 + wh) * 32 + un.pm;
                    __syncthreads();
                    if (tidx() == 0) { __threadfence(); __hip_atomic_fetch_add(cnt, 1u, __ATOMIC_RELAXED, __HIP_MEMORY_SCOPE_AGENT);
                        while (__hip_atomic_load(cnt, __ATOMIC_RELAXED, __HIP_MEMORY_SCOPE_AGENT) < 8u) __builtin_amdgcn_s_sleep(2);
                        __threadfence(); }
                    __syncthreads();
                    const int tid2 = tidx(), lane2 = tid2 & 63, wave2 = __builtin_amdgcn_readfirstlane(tid2 >> 6);
                    const float* g = p.in[s == 1 ? 4 : (s == 11 ? 34 : 38)] + l * DM;
                    row_phase(H, nullptr, (ph == NPH - 2) ? p.out : nullptr, XB, RS, g, s == 11 ? 1.0f : 0.5f, wave2, lane2, un.pm * 256 + un.pn * 32, 32);
                }
            } else if ((s == 2 || s == 12 || s == 15) && PON(3) && gridDim.x != 256) {
                const float* g = p.in[s == 2 ? 4 : (s == 12 ? 34 : 38)] + l * DM;
                row_phase(H, nullptr, (ph == NPH - 1) ? p.out : nullptr, XB, RS, g, s == 12 ? 1.0f : 0.5f, wave, lane);
            } else if (s == 3 && PON(4)) {
                EpiIN E; E.ZR = (float*)(ws + WS_ZR); E.DAQK = (bf16_t*)(ws + WS_DAQK); E.VT = (bf16_t*)(ws + WS_VT); E.ZS = (float*)(ws + WS_ZS); E.rs = RS;
                run_gemm(lds, XB, (const bf16_t*)(ws + WS_WIN + (size_t)l * SZ_WIN), INC, DM, E);
            } else if (s == 4 && PON(5)) {
                la_prep(p, l);
                s5_scan<1>(p, l, wave - 4, 4, bidx(), gridDim.x, lane, lds);
            } else if (s == 6 && PON(7)) {
                rwkv_scan<1>(p, l, wave, lane, lds);
                s5_scan<2>(p, l, (wave == 3) ? 0 : ((wave == 7) ? 1 : -1), 2, bidx(), gridDim.x, lane, lds + 24576);
            } else if ((s == 7 || s == 9) && PON(8)) {
                const int tid_ = tidx(), lane = tid_ & 63, wave = __builtin_amdgcn_readfirstlane(tid_ >> 6);
                const int G = gridDim.x; bool do_attn = true;
                if (s == 7) {
                    if (G >= 48) {
                        if (bidx() < 24) { rwkv_combine(p, bidx(), wave, lane, lds);
                            __syncthreads(); if (tidx() == 0) __hip_atomic_fetch_add((unsigned*)ws + 264 + l, 1u, __ATOMIC_RELAXED, __HIP_MEMORY_SCOPE_AGENT);
                            do_attn = false; }
                        else if (l == 0) { for (int gt = 2536 + bidx() - 24; gt < 2536 + 1376; gt += G - 24) weight_tile(p, gt, lds); }
                    } else {
                        for (int bh = bidx(); bh < 24; bh += G) rwkv_combine(p, bh, wave, lane, lds);
                        if (l == 0) { __syncthreads(); for (int gt = 2536 + bidx(); gt < 2536 + 1376; gt += G) weight_tile(p, gt, lds); }
                        do_attn = false;
                    }
                } else {
                    EpiGLU E; E.YCAT = YCAT; E.YS = (const float*)(ws + WS_YS); E.bglu = p.in[32] + l * 512;
                    run_gemm(lds, (const bf16_t*)(ws + WS_YSB), (const bf16_t*)(ws + WS_WGLU + (size_t)l * SZ_WGLU), 512, 512, E);
                }
                if (do_attn && PON(11)) attn_phase(p, l, wave, lane, lds, s == 7);
            } else if (s == 8 && PON(9)) {
                rwkv_out(p, l, wave, lane, lds);
            }
        }
        }
        { const int sx = (ph > 0) ? (ph - 1) % NPL : -1; const bool skip = (sx == 10) || (gridDim.x == 256 && (sx == 2 || sx == 12 || sx == 15));
          if (ph + 1 < p.ph_hi && !skip) {
              if (ph == p.ph_lo) grid.sync();
              else {
                  asm volatile("s_waitcnt vmcnt(0)" ::: "memory");
                  __syncthreads();
                  if (threadIdx.x == 0) {
                      unsigned* wsw = (unsigned*)p.ws; unsigned* base = wsw + 16384 + ph * 4096;
                      const unsigned xcc = (unsigned)__builtin_amdgcn_s_getreg((3 << 11) | 20) & 0xFu;
                      unsigned nloc = xst[0], nx = xst[1];
                      if (nloc == 0u) {
                          nx = 0u;
#pragma unroll
                          for (unsigned j = 0; j < 16; ++j) { const unsigned cj = __hip_atomic_load(wsw + 1536 + j, __ATOMIC_RELAXED, __HIP_MEMORY_SCOPE_AGENT); nx += (cj > 0u) ? 1u : 0u; nloc = (j == xcc) ? cj : nloc; }
                          xst[0] = nloc; xst[1] = nx;
                      }
                      const unsigned old = __hip_atomic_fetch_add(base + xcc * 64, 1u, __ATOMIC_RELAXED, __HIP_MEMORY_SCOPE_AGENT);
                      if (old + 1u == nloc) {
                          __builtin_amdgcn_fence(__ATOMIC_RELEASE, "agent");
                          asm volatile("s_waitcnt vmcnt(0)" ::: "memory");
                          const unsigned ot = __hip_atomic_fetch_add(base + 2048, 1u, __ATOMIC_RELAXED, __HIP_MEMORY_SCOPE_AGENT);
                          if (ot + 1u != nx) while (__hip_atomic_load(base + 2048, __ATOMIC_RELAXED, __HIP_MEMORY_SCOPE_AGENT) < nx) __builtin_amdgcn_s_sleep(1);
                          __builtin_amdgcn_fence(__ATOMIC_ACQUIRE, "agent");
                          __hip_atomic_fetch_add(base + 1024 + xcc * 64, 1u, __ATOMIC_RELAXED, __HIP_MEMORY_SCOPE_AGENT);
                          asm volatile("s_waitcnt vmcnt(0)" ::: "memory");
                      } else {
                          while (__hip_atomic_load(base + 1024 + xcc * 64, __ATOMIC_RELAXED, __HIP_MEMORY_SCOPE_AGENT) == 0u) __builtin_amdgcn_s_sleep(1);
                          __builtin_amdgcn_fence(__ATOMIC_ACQUIRE, "agent");
                          asm volatile("s_waitcnt vmcnt(0)" ::: "memory");
                      }
                  }
                  __syncthreads();
              }
          } }
    }
}

extern "C" void kernel_launch(void* const* d_in, const int* in_sizes, int n_in, void* d_out, int out_size, void* d_ws, size_t ws_size, hipStream_t stream) {
    static int grid = 0;
    if (grid == 0) {
        if (n_in != 39 || out_size != MT * DM || ws_size < WS_END) { fprintf(stderr, "kernel_launch: unexpected sizes: n_in %d out %d ws %zu (need %zu)\n", n_in, out_size, ws_size, (size_t)WS_END); grid = -1; return; }
        int dev = 0, cus = 0, per_cu = 0;
        hipGetDevice(&dev); hipDeviceGetAttribute(&cus, hipDeviceAttributeMultiprocessorCount, dev);
        if (hipFuncSetAttribute((const void*)mk_fwd, hipFuncAttributeMaxDynamicSharedMemorySize, LDS_BYTES) != hipSuccess) { fprintf(stderr, "kernel_launch: hipFuncSetAttribute failed\n"); grid = -1; return; }
        if (hipOccupancyMaxActiveBlocksPerMultiprocessor(&per_cu, (const void*)mk_fwd, 512, LDS_BYTES) != hipSuccess || per_cu < 1) { fprintf(stderr, "kernel_launch: occupancy query gives %d\n", per_cu); per_cu = 1; }
        (void)hipGetLastError();
        grid = cus * 1;
        fprintf(stderr, "kernel_launch: cus %d per_cu %d grid %d\n", cus, per_cu, grid);
    }
    if (grid < 0) return;
    if (hipMemsetAsync(d_ws, 0, 1u << 20, stream) != hipSuccess) { fprintf(stderr, "kernel_launch: hipMemsetAsync failed\n"); return; }
    Params a{};
    for (int i = 0; i < 39; ++i) a.in[i] = (const float*)d_in[i];
    a.out = (float*)d_out; a.ws = (unsigned char*)d_ws;
#if ONE_LAUNCH
    a.ph_lo = 0; a.ph_hi = NPH;
    void* args[] = {&a};
    hipError_t e = hipLaunchCooperativeKernel((const void*)mk_fwd, dim3(grid), dim3(512), args, LDS_BYTES, stream);
    if (e != hipSuccess) fprintf(stderr, "cooperative launch failed: %s (grid %d)\n", hipGetErrorString(e), grid);
#else
    for (int ph = 0; ph < NPH; ++ph) {
        a.ph_lo = ph; a.ph_hi = ph + 1;
        hipLaunchKernelGGL(mk_fwd, dim3(grid), dim3(512), LDS_BYTES, stream, a);
    }
#endif
}
```
